# Optimizing an MI355X kernel written in HIP

```python
import numpy as np
import jax
import jax.numpy as jnp
from jax import lax

D_MODEL = 1024
BATCH = 8
SEQ = 4096
DEPTH = 4

HEAD_DIM = 64
ROPE_THETA = 10000.0
EPS = 1e-6
Q_BLOCK = 128
NEG_INF = -1e30
FORCE_SCORE = 1e4
N_MOD = 9
D_FF = 2816
A_HEADS = 4
A_KV_HEADS = 2
A_WINDOW = 128
B_HEADS = 4
B_Q_LORA = 256
B_KV_LORA = 128
B_NOPE = 64
B_ROPE = 32
B_V = 64
C_HEADS = 8
C_KV_HEADS = 2
C_CMP_BLOCK = 32
C_CMP_STRIDE = 16
C_SLC_BLOCK = 64
C_N_SEL = 8
C_WINDOW = 256
C_CMP_HID = 128
C_GATE_HID = 64
IN_WIDTHS = (A_HEADS * HEAD_DIM, A_KV_HEADS * HEAD_DIM, A_KV_HEADS * HEAD_DIM,
             B_Q_LORA, B_KV_LORA, B_ROPE,
             C_HEADS * HEAD_DIM) + (C_KV_HEADS * HEAD_DIM,) * 6 + (C_GATE_HID,)
D_IN = sum(IN_WIDTHS)
D_MIX = A_HEADS * HEAD_DIM + B_HEADS * B_V + C_HEADS * HEAD_DIM

kernel_name = 'hybrid_swa_mla_nsa_macaron_adaln'


def rms_norm(x, g):
    xf = x.astype(jnp.float32)
    y = xf * lax.rsqrt(jnp.mean(xf * xf, axis=-1, keepdims=True) + EPS)
    return (y * g.astype(jnp.float32)).astype(x.dtype)


def rope_tables(positions, dim):
    inv_freq = 1.0 / (ROPE_THETA ** (jnp.arange(0, dim, 2, dtype=jnp.float32) / dim))
    ang = positions.astype(jnp.float32)[..., None] * inv_freq
    return jnp.cos(ang), jnp.sin(ang)


def apply_rope(x, cos, sin):
    xf = x.astype(jnp.float32)
    x1, x2 = jnp.split(xf, 2, axis=-1)
    c, s = cos[:, :, None, :], sin[:, :, None, :]
    return jnp.concatenate([x1 * c - x2 * s, x2 * c + x1 * s], axis=-1).astype(x.dtype)


def swiglu(u, w_in, w_out):
    gate, up = jnp.split(u @ w_in, 2, axis=-1)
    return (jax.nn.silu(gate) * up) @ w_out


def banded_attention(q, k, v, window, sinks=None):
    b, t, h, d = q.shape
    hkv = k.shape[2]
    g = h // hkv
    nb = t // Q_BLOCK
    npv = window // Q_BLOCK
    qb = q.reshape(b, nb, Q_BLOCK, hkv, g, d)

    def band(z):
        zb = z.reshape(b, nb, Q_BLOCK, hkv, z.shape[-1])
        zp = jnp.pad(zb, ((0, 0), (npv, 0), (0, 0), (0, 0), (0, 0)))
        return jnp.concatenate([zp[:, i:i + nb] for i in range(npv + 1)], axis=2)

    kb, vb = band(k), band(v)
    s = jnp.einsum('bnqhgd,bnkhd->bhgnqk', qb, kb).astype(jnp.float32) * (d ** -0.5)
    n_keys = (npv + 1) * Q_BLOCK
    rel = (jnp.arange(Q_BLOCK)[:, None] + npv * Q_BLOCK) - jnp.arange(n_keys)[None, :]
    k_abs = jnp.arange(nb)[:, None] * Q_BLOCK + jnp.arange(n_keys)[None, :] - npv * Q_BLOCK
    mask = ((rel >= 0) & (rel < window))[None] & (k_abs >= 0)[:, None, :]
    s = jnp.where(mask, s, NEG_INF)
    if sinks is None:
        p = jax.nn.softmax(s, axis=-1)
    else:
        sink = jnp.broadcast_to(sinks.astype(jnp.float32).reshape(1, hkv, g, 1, 1, 1), s.shape[:-1] + (1,))
        p = jax.nn.softmax(jnp.concatenate([s, sink], axis=-1), axis=-1)[..., :-1]
    o = jnp.einsum('bhgnqk,bnkhd->bnqhgd', p.astype(v.dtype), vb)
    return o.reshape(b, t, h, v.shape[-1])


def causal_attention(q, k, v):
    b, t, h, dq = q.shape
    nb = t // Q_BLOCK
    scale = dq ** -0.5
    qb = jnp.moveaxis(q.reshape(b, nb, Q_BLOCK, h, dq), 1, 0)
    k_pos = jnp.arange(t)

    def one(args):
        qi, n = args
        s = jnp.einsum('bqhd,bkhd->bhqk', qi, k).astype(jnp.float32) * scale
        q_pos = n * Q_BLOCK + jnp.arange(Q_BLOCK)
        s = jnp.where(k_pos[None, :] <= q_pos[:, None], s, NEG_INF)
        p = jax.nn.softmax(s, axis=-1).astype(v.dtype)
        return jnp.einsum('bhqk,bkhd->bqhd', p, v)

    o = lax.map(one, (qb, jnp.arange(nb)))
    return jnp.moveaxis(o, 0, 1).reshape(b, t, h, v.shape[-1])


def compress_blocks(z, pe, w1, w2):
    b, t, hkv, d = z.shape
    n_chunk = t // C_CMP_STRIDE
    r = C_CMP_BLOCK // C_CMP_STRIDE
    n_cmp = n_chunk - r + 1
    zc = z.reshape(b, n_chunk, C_CMP_STRIDE, hkv, d)
    blocks = jnp.concatenate([zc[:, i:i + n_cmp] for i in range(r)], axis=2)
    blocks = blocks + pe[None, None, :, None, :]
    flat = jnp.moveaxis(blocks, 3, 2).reshape(b, n_cmp, hkv, C_CMP_BLOCK * d)
    return jax.nn.silu(flat @ w1) @ w2


def nsa_compressed_selected(q, q_rot, k_cmp, v_cmp, k_slc, v_slc):
    b, t, h, d = q.shape
    hkv = k_cmp.shape[2]
    g = h // hkv
    n_cmp = k_cmp.shape[1]
    n_slc = t // C_SLC_BLOCK
    n_sel = min(C_N_SEL, n_slc)
    nb = t // Q_BLOCK
    scale = d ** -0.5
    ci = np.arange(n_cmp)[:, None] * C_CMP_STRIDE
    sj = np.arange(n_slc)[None, :] * C_SLC_BLOCK
    overlap = jnp.asarray((ci <= sj + C_SLC_BLOCK - 1) & (ci + C_CMP_BLOCK - 1 >= sj), dtype=jnp.float32)
    cmp_end = jnp.arange(n_cmp) * C_CMP_STRIDE + (C_CMP_BLOCK - 1)
    s_blk = jnp.arange(n_slc)
    kb = jnp.moveaxis(k_slc.reshape(b, n_slc, C_SLC_BLOCK, hkv, d), 3, 1)
    vb = jnp.moveaxis(v_slc.reshape(b, n_slc, C_SLC_BLOCK, hkv, d), 3, 1)
    gather = jax.vmap(jax.vmap(lambda blocks, i: blocks[i]))

    def to_blocks(z):
        return jnp.moveaxis(z.reshape(b, nb, Q_BLOCK, hkv, g, d), 1, 0)

    def one(args):
        qc, qr, n = args
        q_pos = n * Q_BLOCK + jnp.arange(Q_BLOCK)
        s = jnp.einsum('bqhgd,bjhd->bhgqj', qc, k_cmp).astype(jnp.float32) * scale
        vis = cmp_end[None, :] <= q_pos[:, None]
        p = jnp.where(vis, jax.nn.softmax(jnp.where(vis, s, NEG_INF), axis=-1), 0.0)
        o_cmp = jnp.einsum('bhgqj,bjhd->bqhgd', p.astype(v_cmp.dtype), v_cmp)
        imp = jnp.einsum('bhgqj,js->bhqs', p, overlap)
        cur = q_pos // C_SLC_BLOCK
        forced = (s_blk[None, :] == 0) | (s_blk[None, :] == cur[:, None]) | (s_blk[None, :] == cur[:, None] - 1)
        future = s_blk[None, :] > cur[:, None]
        score = jnp.where(future, NEG_INF, jnp.where(forced, FORCE_SCORE, imp))
        top_val, idx = lax.top_k(score, n_sel)
        blk_ok = top_val > 0.5 * NEG_INF
        kg = gather(kb, idx)
        vg = gather(vb, idx)
        s2 = jnp.einsum('bqhgd,bhqnld->bhgqnl', qr, kg).astype(jnp.float32) * scale
        tok = idx[..., None] * C_SLC_BLOCK + jnp.arange(C_SLC_BLOCK)
        ok = blk_ok[..., None] & (tok <= q_pos[None, None, :, None, None])
        s2 = jnp.where(ok[:, :, None], s2, NEG_INF)
        p2 = jax.nn.softmax(s2.reshape(b, hkv, g, Q_BLOCK, -1), axis=-1).reshape(s2.shape)
        o_slc = jnp.einsum('bhgqnl,bhqnld->bqhgd', p2.astype(vg.dtype), vg)
        return o_cmp.reshape(b, Q_BLOCK, h, d), o_slc.reshape(b, Q_BLOCK, h, d)

    o_cmp, o_slc = lax.map(one, (to_blocks(q), to_blocks(q_rot), jnp.arange(nb)))
    o_cmp = jnp.moveaxis(o_cmp, 0, 1).reshape(b, t, h, d)
    o_slc = jnp.moveaxis(o_slc, 0, 1).reshape(b, t, h, d)
    return o_cmp, o_slc


def hybrid_mixer(u, cos64, sin64, cos32, sin32, w_in, w_out, a_sinks, a_qk_g,
                 b_q_lat_g, b_kv_lat_g, b_w_uq, b_w_ukv, b_qk_nope_g, b_qk_rope_g,
                 c_qk_g, c_cmp_pe, c_cmp_w1, c_cmp_w2, c_gate_w, c_gate_b):
    b, t, _ = u.shape
    splits = np.cumsum(IN_WIDTHS)[:-1].tolist()
    (a_q, a_k, a_v, b_cq, b_ckv, b_kr, c_q,
     c_kc, c_vc, c_ks, c_vs, c_kw, c_vw, c_gf) = jnp.split(u @ w_in, splits, axis=-1)

    def heads(z, n):
        return z.reshape(b, t, n, z.shape[-1] // n)

    qa = apply_rope(rms_norm(heads(a_q, A_HEADS), a_qk_g[0]), cos64, sin64)
    ka = apply_rope(rms_norm(heads(a_k, A_KV_HEADS), a_qk_g[1]), cos64, sin64)
    o_a = banded_attention(qa, ka, heads(a_v, A_KV_HEADS), A_WINDOW, a_sinks)

    q_b = heads(rms_norm(b_cq, b_q_lat_g) @ b_w_uq, B_HEADS)
    kv_b = heads(rms_norm(b_ckv, b_kv_lat_g) @ b_w_ukv, B_HEADS)
    q_nope = rms_norm(q_b[..., :B_NOPE], b_qk_nope_g[0])
    q_pe = apply_rope(rms_norm(q_b[..., B_NOPE:], b_qk_rope_g[0]), cos32, sin32)
    k_nope = rms_norm(kv_b[..., :B_NOPE], b_qk_nope_g[1])
    v_b = kv_b[..., B_NOPE:]
    k_pe = apply_rope(rms_norm(b_kr[:, :, None, :], b_qk_rope_g[1]), cos32, sin32)
    k_b = jnp.concatenate([k_nope, jnp.broadcast_to(k_pe, (b, t, B_HEADS, B_ROPE))], axis=-1)
    o_b = causal_attention(jnp.concatenate([q_nope, q_pe], axis=-1), k_b, v_b)

    qc = rms_norm(heads(c_q, C_HEADS), c_qk_g[0])
    qc_rot = apply_rope(qc, cos64, sin64)
    k_cmp = rms_norm(compress_blocks(heads(c_kc, C_KV_HEADS), c_cmp_pe[0], c_cmp_w1[0], c_cmp_w2[0]), c_qk_g[1])
    v_cmp = compress_blocks(heads(c_vc, C_KV_HEADS), c_cmp_pe[1], c_cmp_w1[1], c_cmp_w2[1])
    k_slc = apply_rope(rms_norm(heads(c_ks, C_KV_HEADS), c_qk_g[2]), cos64, sin64)
    k_win = apply_rope(rms_norm(heads(c_kw, C_KV_HEADS), c_qk_g[3]), cos64, sin64)
    o_cmp, o_slc = nsa_compressed_selected(qc, qc_rot, k_cmp, v_cmp, k_slc, heads(c_vs, C_KV_HEADS))
    o_win = banded_attention(qc_rot, k_win, heads(c_vw, C_KV_HEADS), C_WINDOW)
    gates = jax.nn.sigmoid(jax.nn.silu(c_gf) @ c_gate_w + c_gate_b).reshape(b, t, C_HEADS, 3)
    o_c = gates[..., 0:1] * o_cmp + gates[..., 1:2] * o_slc + gates[..., 2:3] * o_win

    o = jnp.concatenate([o_a.reshape(b, t, -1), o_b.reshape(b, t, -1), o_c.reshape(b, t, -1)], axis=-1)
    return o @ w_out


def setup_inputs(seed: int = 0) -> dict:
    key = jax.random.key(seed)
    ks = jax.random.split(key, 25)

    def nrm(k, shape, s):
        return jax.random.normal(k, shape, jnp.float32) * s

    def gain(k, shape):
        return 1.0 + 0.05 * jax.random.normal(k, shape, jnp.float32)

    x = nrm(ks[0], (BATCH, SEQ, D_MODEL), 1.0)
    c = nrm(ks[1], (BATCH, D_MODEL), 1.0)
    offsets = jax.random.randint(ks[2], (BATCH, 1), 0, 1024, dtype=jnp.int32)
    positions = (offsets + jnp.arange(SEQ, dtype=jnp.int32)[None, :]).astype(jnp.int32)
    return {
        'x': x,
        'c': c,
        'positions': positions,
        'ada_w': nrm(ks[3], (DEPTH, D_MODEL, N_MOD * D_MODEL), 0.5 * D_MODEL ** -0.5),
        'ada_b': nrm(ks[4], (DEPTH, N_MOD * D_MODEL), 0.02),
        'norm_g': gain(ks[5], (DEPTH, 3, D_MODEL)),
        'ffn_w_in': nrm(ks[6], (DEPTH, 2, D_MODEL, 2 * D_FF), D_MODEL ** -0.5),
        'ffn_w_out': nrm(ks[7], (DEPTH, 2, D_FF, D_MODEL), D_FF ** -0.5),
        'w_in': nrm(ks[8], (DEPTH, D_MODEL, D_IN), D_MODEL ** -0.5),
        'w_out': nrm(ks[9], (DEPTH, D_MIX, D_MODEL), D_MIX ** -0.5),
        'a_sinks': nrm(ks[10], (DEPTH, A_HEADS), 0.5),
        'a_qk_g': gain(ks[11], (DEPTH, 2, HEAD_DIM)),
        'b_q_lat_g': gain(ks[12], (DEPTH, B_Q_LORA)),
        'b_kv_lat_g': gain(ks[13], (DEPTH, B_KV_LORA)),
        'b_w_uq': nrm(ks[14], (DEPTH, B_Q_LORA, B_HEADS * (B_NOPE + B_ROPE)), B_Q_LORA ** -0.5),
        'b_w_ukv': nrm(ks[15], (DEPTH, B_KV_LORA, B_HEADS * (B_NOPE + B_V)), B_KV_LORA ** -0.5),
        'b_qk_nope_g': gain(ks[16], (DEPTH, 2, B_NOPE)),
        'b_qk_rope_g': gain(ks[17], (DEPTH, 2, B_ROPE)),
        'c_qk_g': gain(ks[18], (DEPTH, 4, HEAD_DIM)),
        'c_cmp_pe': nrm(ks[19], (DEPTH, 2, C_CMP_BLOCK, HEAD_DIM), 0.2),
        'c_cmp_w1': nrm(ks[20], (DEPTH, 2, C_CMP_BLOCK * HEAD_DIM, C_CMP_HID), (C_CMP_BLOCK * HEAD_DIM) ** -0.5),
        'c_cmp_w2': nrm(ks[21], (DEPTH, 2, C_CMP_HID, HEAD_DIM), C_CMP_HID ** -0.5),
        'c_gate_w': nrm(ks[22], (DEPTH, C_GATE_HID, C_HEADS * 3), C_GATE_HID ** -0.5),
        'c_gate_b': nrm(ks[23], (DEPTH, C_HEADS * 3), 0.02),
    }


def reference(x, c, positions, ada_w, ada_b, norm_g, ffn_w_in, ffn_w_out, w_in, w_out,
              a_sinks, a_qk_g, b_q_lat_g, b_kv_lat_g, b_w_uq, b_w_ukv, b_qk_nope_g, b_qk_rope_g,
              c_qk_g, c_cmp_pe, c_cmp_w1, c_cmp_w2, c_gate_w, c_gate_b):
    bsz, _, dm = x.shape
    cos64, sin64 = rope_tables(positions, HEAD_DIM)
    cos32, sin32 = rope_tables(positions, B_ROPE)
    cond = jax.nn.silu(c)
    h = x
    for l in range(DEPTH):
        mod = (cond @ ada_w[l] + ada_b[l]).reshape(bsz, N_MOD, 1, dm)
        sh1, sc1, g1, sh2, sc2, g2, sh3, sc3, g3 = [mod[:, i] for i in range(N_MOD)]
        u = rms_norm(h, norm_g[l, 0]) * (1.0 + sc1) + sh1
        h = h + 0.5 * g1 * swiglu(u, ffn_w_in[l, 0], ffn_w_out[l, 0])
        u = rms_norm(h, norm_g[l, 1]) * (1.0 + sc2) + sh2
        h = h + g2 * hybrid_mixer(u, cos64, sin64, cos32, sin32, w_in[l], w_out[l], a_sinks[l], a_qk_g[l],
                                  b_q_lat_g[l], b_kv_lat_g[l], b_w_uq[l], b_w_ukv[l], b_qk_nope_g[l],
                                  b_qk_rope_g[l], c_qk_g[l], c_cmp_pe[l], c_cmp_w1[l], c_cmp_w2[l],
                                  c_gate_w[l], c_gate_b[l])
        u = rms_norm(h, norm_g[l, 2]) * (1.0 + sc3) + sh3
        h = h + 0.5 * g3 * swiglu(u, ffn_w_in[l, 1], ffn_w_out[l, 1])
    return h
```

```cpp
#include <hip/hip_runtime.h>
#include <hip/hip_cooperative_groups.h>
#include <cstdio>
#include <cstdint>
namespace cg = cooperative_groups;

#define LAS __attribute__((address_space(3)))
typedef unsigned short bf16_t;
typedef short bf16x8 __attribute__((ext_vector_type(8)));
typedef short bf16x4 __attribute__((ext_vector_type(4)));
typedef float f32x4 __attribute__((ext_vector_type(4)));
typedef float f32x2 __attribute__((ext_vector_type(2)));
typedef unsigned u32x4 __attribute__((ext_vector_type(4)));
typedef unsigned u32x2 __attribute__((ext_vector_type(2)));
typedef __bf16 bf16x2_t __attribute__((ext_vector_type(2)));

#ifndef PHM
#define PHM 0xffff
#endif
#define PHON(n) (((PHM) >> (n)) & 1)
#ifndef DUPM
#define DUPM 0
#endif
#define NREP(n) (1 + (((DUPM) >> (n)) & 1))
#ifndef DUPU
#define DUPU 0
#endif
#define UREP(n) (1 + (((DUPU) >> (n)) & 1))
#ifndef FUSE_NORM
#define FUSE_NORM 1
#endif
#ifndef MK_ONE_LAUNCH
#define MK_ONE_LAUNCH 1
#endif

constexpr int DM = 1024, NBATCH = 8, SEQ = 4096, T = NBATCH * SEQ, DEPTH = 4, DFF = 2816, NMOD = 9;
constexpr int DIN = 2272, DINP = 2304;
constexpr float EPS = 1e-6f, LOG2E = 1.4426950408889634f;
constexpr int NTHREADS = 512, NWAVES = 8;

constexpr size_t MiB = 1u << 20;
constexpr size_t WS_MOD = 0;
constexpr size_t WS_CMPB = 2 * MiB;
constexpr size_t WS_CMPBP = 2 * MiB + 65536;
constexpr size_t WS_BAR = 2 * MiB + 524288, BAR_BYTES = 16384 + 8192;
constexpr size_t WS_XBUF = 15 * MiB;
constexpr size_t WS_COS64 = 3 * MiB, WS_SIN64 = 7 * MiB, WS_COS32 = 11 * MiB, WS_SIN32 = 13 * MiB;
constexpr size_t WS_W1T = 16 * MiB;
constexpr size_t WS_W2T = 104 * MiB;
constexpr size_t WS_WINT = 148 * MiB;
constexpr size_t WS_WOUTT = 166 * MiB;
constexpr size_t WS_WUQT = 174 * MiB;
constexpr size_t WS_WUKVT = 175 * MiB;
constexpr size_t WS_WC1T = 176 * MiB;
constexpr size_t WS_U = 180 * MiB;
constexpr size_t WS_R1 = 244 * MiB;
constexpr size_t WS_R2 = 420 * MiB;
constexpr size_t WS_END = 596 * MiB;
constexpr size_t R1_HIDP = 130 * MiB;
constexpr size_t R1_QBR = 0, R1_KVBR = 32 * MiB, R1_HID = 64 * MiB, R1_QB = 66 * MiB, R1_KB = 90 * MiB, R1_VB = 114 * MiB, R1_OWIN = 0, R1_OCMP = 32 * MiB;
constexpr size_t R2_QA = 0, R2_KA = 16 * MiB, R2_VA = 24 * MiB, R2_CQN = 32 * MiB, R2_CKVN = 48 * MiB, R2_KPE = 56 * MiB, R2_QC = 58 * MiB, R2_QCR = 90 * MiB,
                 R2_ZK = 122 * MiB, R2_ZV = 130 * MiB, R2_KS = 139 * MiB, R2_VS = 147 * MiB, R2_KW = 155 * MiB, R2_VW = 163 * MiB, R2_GATES = 171 * MiB,
                 R2_KCMP = 174 * MiB, R2_VCMP = 174 * MiB + 512 * 1024, R2_SEL = 175 * MiB;

__device__ __forceinline__ unsigned cvtpk(float lo, float hi) { f32x2 v = {lo, hi}; bf16x2_t b = __builtin_convertvector(v, bf16x2_t); return __builtin_bit_cast(unsigned, b); }
__device__ __forceinline__ unsigned f2bf(float f) { unsigned u = __builtin_bit_cast(unsigned, f); return (u + 0x7fffu + ((u >> 16) & 1u)) >> 16; }
__device__ __forceinline__ unsigned pk2(float lo, float hi) { return f2bf(lo) | (f2bf(hi) << 16); }
__device__ __forceinline__ float bf2f(unsigned h) { return __builtin_bit_cast(float, h << 16); }
__device__ __forceinline__ float wave_sum(float v) {
#pragma unroll
    for (int o = 1; o < 64; o <<= 1) v += __shfl_xor(v, o);
    return v;
}
__device__ __forceinline__ float wave_max(float v) {
#pragma unroll
    for (int o = 1; o < 64; o <<= 1) v = fmaxf(v, __shfl_xor(v, o));
    return v;
}
__device__ __forceinline__ float uniform_f(float v) { return __builtin_bit_cast(float, __builtin_amdgcn_readfirstlane(__builtin_bit_cast(int, v))); }
__device__ __forceinline__ float fast_exp2(float x) { return __builtin_amdgcn_exp2f(x); }
__device__ __forceinline__ float silu_f(float g) { return g * __builtin_amdgcn_rcpf(1.0f + fast_exp2(-g * LOG2E)); }
#define LDS_WAIT() asm volatile("s_waitcnt lgkmcnt(0)" ::: "memory")

namespace pg8 {
constexpr int BM = 256, BK = 64, HALF = 128, HTB = HALF * BK * 2, STAGE_BYTES = 8 * HTB, NXCD = 8, WGM = 8;
__host__ __device__ __forceinline__ int lds_byte(int r, int c) { const int st = (r >> 4) * 2 + (c >> 5), rr = r & 15, cc = c & 31, ob = rr * 64 + cc * 2; return st * 1024 + (ob ^ (((ob >> 9) & 1) << 5)); }
__host__ __device__ __forceinline__ void stage_rc(int b, int& R, int& C) { const int st = b / 1024, sb = b % 1024, swz = sb ^ (((sb >> 9) & 1) << 5); R = (st >> 1) * 16 + swz / 64; C = (st & 1) * 32 + (swz % 64) / 2; }
__host__ __device__ __forceinline__ int perm32(int rho) { const int n = rho >> 4, i = rho & 15; return 8 * (i >> 2) + 4 * n + (i & 3); }

struct Unit { int pm, pn; };
struct Gemm { const bf16_t* A; const bf16_t* Bt; int lda, ldb, M, N, K; int ksb = 0; };

struct StaticOrder {
    int nM, nN, nwg, G, c;
    __device__ void init(int M, int N, int G_, int c_) { nM = M / BM; nN = N / BM; nwg = nM * nN; G = G_; c = c_; }
    __device__ bool next(int i, Unit& u) const {
        const long L = (long)i * G + c; if (L >= nwg) return false;
        int wgid = (int)L; { const int q = nwg / NXCD, r = nwg % NXCD, xcd = wgid % NXCD, off = wgid / NXCD; wgid = (xcd < r ? xcd * (q + 1) : r * (q + 1) + (xcd - r) * q) + off; }
        const int nig = WGM * nN, gid = wgid / nig, fm = gid * WGM, gsz = (nM - fm) < WGM ? (nM - fm) : WGM;
        u.pm = fm + ((wgid % nig) % gsz); u.pn = (wgid % nig) / gsz; return true;
    }
};

struct EpiMixIn {
    static constexpr bool PERM = true;
    bf16_t *QA, *KA, *VA, *QC, *QCR, *ZK, *ZV, *KS, *VS, *KW, *VW, *P2;
    const float *gaq, *gak, *gcq, *gcs, *gcw, *C64, *S64;
    __device__ __forceinline__ void operator()(const f32x4 (&acc)[2][2][4][2], const Unit& u, int wr, int wc, int fr, int fq) const {
        const int pn = u.pn, row0 = u.pm * BM + wr * 64 + fr;
        if (pn >= 7) {
            const int col0 = (pn - 7) * BM + wc * 32 + 8 * fq;
#pragma unroll
            for (int ai = 0; ai < 2; ++ai)
#pragma unroll
                for (int m = 0; m < 4; ++m) { bf16_t* rowp = P2 + (size_t)(row0 + ai * HALF + m * 16) * 512 + col0;
#pragma unroll
                    for (int bj = 0; bj < 2; ++bj) { const f32x4 v0 = acc[ai][bj][m][0], v1 = acc[ai][bj][m][1];
                        u32x4 w; w.x = cvtpk(v0[0], v0[1]); w.y = cvtpk(v0[2], v0[3]); w.z = cvtpk(v1[0], v1[1]); w.w = cvtpk(v1[2], v1[3]);
                        *(u32x4*)(rowp + bj * HALF) = w; } }
            return;
        }
        bf16_t* dst; const float* gp = nullptr; int Hn, h; bool rope = false; float scale = 1.0f; bool two = false;
        const bool lo = wc < 2; const int h2 = wc & 1;
        if (pn == 0) { dst = QA; Hn = 4; h = wc; gp = gaq; rope = true; scale = 0.125f * LOG2E; }
        else if (pn == 1) { Hn = 2; h = h2; if (lo) { dst = KA; gp = gak; rope = true; } else dst = VA; }
        else if (pn <= 3) { dst = QCR; Hn = 8; h = 4 * (pn - 2) + wc; gp = gcq; rope = true; scale = 0.125f * LOG2E; two = true; }
        else if (pn == 4) { Hn = 2; h = h2; dst = lo ? ZK : ZV; }
        else if (pn == 5) { Hn = 2; h = h2; if (lo) { dst = KS; gp = gcs; rope = true; } else dst = VS; }
        else { Hn = 2; h = h2; if (lo) { dst = KW; gp = gcw; rope = true; } else dst = VW; }
        f32x4 ga[2], gb[2];
#pragma unroll
        for (int n = 0; n < 2; ++n) { ga[n] = gp ? *(const f32x4*)(gp + 8 * fq + 4 * n) : (f32x4){1.f, 1.f, 1.f, 1.f}; gb[n] = gp ? *(const f32x4*)(gp + 32 + 8 * fq + 4 * n) : (f32x4){1.f, 1.f, 1.f, 1.f}; }
        const int b = u.pm >> 4;
#pragma unroll
        for (int ai = 0; ai < 2; ++ai)
#pragma unroll
            for (int m = 0; m < 4; ++m) {
                const int row = row0 + ai * HALF + m * 16, s_ = row & 4095;
                f32x4 a[2], bb[2];
#pragma unroll
                for (int n = 0; n < 2; ++n) { a[n] = acc[ai][0][m][n]; bb[n] = acc[ai][1][m][n]; }
                float r = scale;
                if (gp) { float ss = 0.f;
#pragma unroll
                    for (int n = 0; n < 2; ++n)
#pragma unroll
                        for (int e = 0; e < 4; ++e) ss += a[n][e] * a[n][e] + bb[n][e] * bb[n][e];
                    ss += __shfl_xor(ss, 16); ss += __shfl_xor(ss, 32);
                    r = rsqrtf(ss * (1.0f / 64) + EPS) * scale; }
#pragma unroll
                for (int n = 0; n < 2; ++n) { a[n] = a[n] * r * ga[n]; bb[n] = bb[n] * r * gb[n]; }
                const size_t o = ((size_t)(b * Hn + h) * SEQ + s_) * 64 + 8 * fq;
                if (two) { u32x4 w; w.x = cvtpk(a[0][0], a[0][1]); w.y = cvtpk(a[0][2], a[0][3]); w.z = cvtpk(a[1][0], a[1][1]); w.w = cvtpk(a[1][2], a[1][3]); *(u32x4*)(QC + o) = w;
                    w.x = cvtpk(bb[0][0], bb[0][1]); w.y = cvtpk(bb[0][2], bb[0][3]); w.z = cvtpk(bb[1][0], bb[1][1]); w.w = cvtpk(bb[1][2], bb[1][3]); *(u32x4*)(QC + o + 32) = w; }
                if (rope) {
#pragma unroll
                    for (int n = 0; n < 2; ++n) { const f32x4 cs = *(const f32x4*)(C64 + (size_t)row * 32 + 8 * fq + 4 * n), sn = *(const f32x4*)(S64 + (size_t)row * 32 + 8 * fq + 4 * n);
                        const f32x4 ya = a[n], yb = bb[n]; a[n] = ya * cs - yb * sn; bb[n] = yb * cs + ya * sn; } }
                u32x4 w; w.x = cvtpk(a[0][0], a[0][1]); w.y = cvtpk(a[0][2], a[0][3]); w.z = cvtpk(a[1][0], a[1][1]); w.w = cvtpk(a[1][2], a[1][3]); *(u32x4*)(dst + o) = w;
                w.x = cvtpk(bb[0][0], bb[0][1]); w.y = cvtpk(bb[0][2], bb[0][3]); w.z = cvtpk(bb[1][0], bb[1][1]); w.w = cvtpk(bb[1][2], bb[1][3]); *(u32x4*)(dst + o + 32) = w;
            }
    }
};
struct EpiMixB {
    static constexpr bool PERM = true;
    bool isq; bf16_t *QB, *KB, *VB; const bf16_t* KPE; const float *gqn, *gqr, *gkn, *C32, *S32;
    __device__ __forceinline__ void operator()(const f32x4 (&acc)[2][2][4][2], const Unit& u, int wr, int wc, int fr, int fq) const {
        const int pn = u.pn, row0 = u.pm * BM + wr * 64 + fr, b = u.pm >> 4;
        const float SC = 0.10206207261596575f * LOG2E;
        const bool rope = isq && pn == 1, isv = !isq && (wc & 1);
        const int h = isq ? wc : 2 * pn + (wc >> 1);
        const float* gp = isq ? (rope ? gqr : gqn) : (isv ? nullptr : gkn);
        const int hstep = rope ? 16 : 32;
        f32x4 ga[2], gb[2];
#pragma unroll
        for (int n = 0; n < 2; ++n) { const bool ok = gp && (!rope || fq < 2);
            ga[n] = ok ? *(const f32x4*)(gp + 8 * fq + 4 * n) : (f32x4){1.f, 1.f, 1.f, 1.f}; gb[n] = ok ? *(const f32x4*)(gp + hstep + 8 * fq + 4 * n) : (f32x4){1.f, 1.f, 1.f, 1.f}; }
#pragma unroll
        for (int ai = 0; ai < 2; ++ai)
#pragma unroll
            for (int m = 0; m < 4; ++m) {
                const int row = row0 + ai * HALF + m * 16, s_ = row & 4095;
                f32x4 a[2], bb[2];
#pragma unroll
                for (int n = 0; n < 2; ++n) { a[n] = acc[ai][0][m][n]; bb[n] = acc[ai][1][m][n]; }
                float r = 1.0f;
                if (gp) { float ss = 0.f;
#pragma unroll
                    for (int n = 0; n < 2; ++n)
#pragma unroll
                        for (int e = 0; e < 4; ++e) ss += a[n][e] * a[n][e] + bb[n][e] * bb[n][e];
                    ss += __shfl_xor(ss, 16); ss += __shfl_xor(ss, 32);
                    r = rsqrtf(ss * (rope ? 1.0f / 32 : 1.0f / 64) + EPS) * (isq ? SC : 1.0f); }
#pragma unroll
                for (int n = 0; n < 2; ++n) { a[n] = a[n] * r * ga[n]; bb[n] = bb[n] * r * gb[n]; }
                if (rope && fq < 2) {
#pragma unroll
                    for (int n = 0; n < 2; ++n) { const f32x4 cs = *(const f32x4*)(C32 + (size_t)row * 16 + 8 * fq + 4 * n), sn = *(const f32x4*)(S32 + (size_t)row * 16 + 8 * fq + 4 * n);
                        const f32x4 ya = a[n], yb = bb[n]; a[n] = ya * cs - yb * sn; bb[n] = yb * cs + ya * sn; } }
                u32x4 wa, wb; wa.x = cvtpk(a[0][0], a[0][1]); wa.y = cvtpk(a[0][2], a[0][3]); wa.z = cvtpk(a[1][0], a[1][1]); wa.w = cvtpk(a[1][2], a[1][3]);
                wb.x = cvtpk(bb[0][0], bb[0][1]); wb.y = cvtpk(bb[0][2], bb[0][3]); wb.z = cvtpk(bb[1][0], bb[1][1]); wb.w = cvtpk(bb[1][2], bb[1][3]);
                const size_t hs = (size_t)(b * 4 + h) * SEQ + s_;
                if (isq) { bf16_t* d = QB + hs * 96;
                    if (!rope) { *(u32x4*)(d + 8 * fq) = wa; *(u32x4*)(d + 32 + 8 * fq) = wb; }
                    else if (fq < 2) { *(u32x4*)(d + 64 + 8 * fq) = wa; *(u32x4*)(d + 80 + 8 * fq) = wb; } }
                else if (!isv) { bf16_t* d = KB + hs * 96; *(u32x4*)(d + 8 * fq) = wa; *(u32x4*)(d + 32 + 8 * fq) = wb;
                    *(u32x4*)(d + 64 + 8 * fq) = *(const u32x4*)(KPE + (size_t)row * 32 + 8 * fq); }
                else { bf16_t* d = VB + hs * 64; *(u32x4*)(d + 8 * fq) = wa; *(u32x4*)(d + 32 + 8 * fq) = wb; }
            }
    }
};
struct EpiSwiglu {
    static constexpr bool PERM = true;
    bf16_t* O;
    __device__ __forceinline__ void operator()(const f32x4 (&acc)[2][2][4][2], const Unit& u, int wr, int wc, int fr, int fq) const {
        const int row0 = u.pm * BM + wr * 64 + fr, col0 = u.pn * HALF + wc * 32 + 8 * fq;
#pragma unroll
        for (int ai = 0; ai < 2; ++ai)
#pragma unroll
            for (int m = 0; m < 4; ++m) { bf16_t* rowp = O + (size_t)(row0 + ai * HALF + m * 16) * DFF + col0;
                float r[8];
#pragma unroll
                for (int n = 0; n < 2; ++n)
#pragma unroll
                    for (int e = 0; e < 4; ++e) r[n * 4 + e] = silu_f(acc[ai][0][m][n][e]) * acc[ai][1][m][n][e];
                u32x4 w; w.x = cvtpk(r[0], r[1]); w.y = cvtpk(r[2], r[3]); w.z = cvtpk(r[4], r[5]); w.w = cvtpk(r[6], r[7]);
                *(u32x4*)rowp = w; }
    }
};
struct EpiResid {
    static constexpr bool PERM = true;
    const float* base; float* out; const float* gate; float coef;
    const float* nxg; const float* nxsc; const float* nxsh; bf16_t* U; float* xbuf; unsigned* cnt; LAS unsigned char* xl;
    __device__ __forceinline__ void operator()(f32x4 (&acc)[2][2][4][2], const Unit& u, int wr, int wc, int fr, int fq) const {
        const float coef_ = uniform_f(coef);
        const unsigned long long nxa = (unsigned long long)(uintptr_t)this->nxg;
        const float* nxg = (const float*)(uintptr_t)(((unsigned long long)(unsigned)__builtin_amdgcn_readfirstlane((int)(nxa >> 32)) << 32) | (unsigned)__builtin_amdgcn_readfirstlane((int)nxa));
        const int b = u.pm >> 4; const float* gv = gate + (size_t)b * (NMOD * DM);
        const int col0 = u.pn * BM + wc * 32 + 8 * fq;
        f32x4 g4[2][2];
#pragma unroll
        for (int bj = 0; bj < 2; ++bj)
#pragma unroll
            for (int n = 0; n < 2; ++n) g4[bj][n] = *(const f32x4*)(gv + col0 + bj * HALF + n * 4) * coef_;
#pragma unroll
        for (int ai = 0; ai < 2; ++ai)
#pragma unroll
            for (int m = 0; m < 4; ++m) { const size_t off = (size_t)(u.pm * BM + wr * 64 + fr + ai * HALF + m * 16) * DM + col0;
#pragma unroll
                for (int bj = 0; bj < 2; ++bj)
#pragma unroll
                    for (int n = 0; n < 2; ++n) { const f32x4 bs = __builtin_nontemporal_load((const f32x4*)(base + off + bj * HALF + n * 4));
                        const f32x4 v = bs + g4[bj][n] * acc[ai][bj][m][n]; __builtin_nontemporal_store(v, (f32x4*)(out + off + bj * HALF + n * 4)); acc[ai][bj][m][n] = v; } }
        if (!nxg) return;
        LAS float* P = (LAS float*)xl; LAS float* S = (LAS float*)(xl + 4096); LAS unsigned* flag = (LAS unsigned*)(xl + 5120);
        const int tid = threadIdx.x, wid = tid >> 6, lane = tid & 63;
#pragma unroll
        for (int ai = 0; ai < 2; ++ai)
#pragma unroll
            for (int m = 0; m < 4; ++m) { float ss = 0.f;
#pragma unroll
                for (int bj = 0; bj < 2; ++bj)
#pragma unroll
                    for (int n = 0; n < 2; ++n) { const f32x4 v = acc[ai][bj][m][n]; ss += (v[0] * v[0] + v[1] * v[1]) + (v[2] * v[2] + v[3] * v[3]); }
                ss += __shfl_xor(ss, 16); ss += __shfl_xor(ss, 32);
                if (fq == 0) P[(ai * HALF + wr * 64 + m * 16 + fr) * 4 + wc] = ss; }
        asm volatile("s_waitcnt lgkmcnt(0)" ::: "memory"); __builtin_amdgcn_s_barrier(); asm volatile("" ::: "memory");
        if (tid < 256) { const float t = (P[tid * 4 + 0] + P[tid * 4 + 1]) + (P[tid * 4 + 2] + P[tid * 4 + 3]);
            __hip_atomic_store(xbuf + ((size_t)(u.pm * BM + tid) * 4 + u.pn), t, __ATOMIC_RELAXED, __HIP_MEMORY_SCOPE_AGENT); }
        asm volatile("s_waitcnt vmcnt(0)" ::: "memory");
        if (tid < 256 && lane == 0) __hip_atomic_fetch_add(cnt + u.pm, 1u, __ATOMIC_RELAXED, __HIP_MEMORY_SCOPE_AGENT);
        if (wid == 0) { unsigned spins = 0; bool dead = false;
            while ((unsigned)__builtin_amdgcn_readfirstlane((int)__hip_atomic_load(cnt + u.pm, __ATOMIC_RELAXED, __HIP_MEMORY_SCOPE_AGENT)) < 16u) { __builtin_amdgcn_s_sleep(2); if (++spins > (1u << 20)) { dead = true; break; } }
            __builtin_amdgcn_fence(__ATOMIC_ACQUIRE, "agent");
            if (lane == 0) flag[0] = dead ? 1u : 0u; }
        asm volatile("s_waitcnt vmcnt(0) lgkmcnt(0)" ::: "memory"); __builtin_amdgcn_s_barrier(); asm volatile("" ::: "memory");
        if (tid < 256) { const float* sl = xbuf + (size_t)(u.pm * BM + tid) * 4; float t = 0.f;
#pragma unroll
            for (int q = 0; q < 4; ++q) t += __hip_atomic_load(sl + q, __ATOMIC_RELAXED, __HIP_MEMORY_SCOPE_AGENT);
            S[tid] = rsqrtf(t * (1.0f / DM) + EPS); }
        asm volatile("s_waitcnt lgkmcnt(0)" ::: "memory"); __builtin_amdgcn_s_barrier(); asm volatile("" ::: "memory");
        const float* scp = nxsc + (size_t)b * (NMOD * DM); const float* shp = nxsh + (size_t)b * (NMOD * DM);
        f32x4 A4[2][2], B4[2][2];
#pragma unroll
        for (int bj = 0; bj < 2; ++bj)
#pragma unroll
            for (int n = 0; n < 2; ++n) { const int c = col0 + bj * HALF + n * 4; A4[bj][n] = *(const f32x4*)(nxg + c) * (*(const f32x4*)(scp + c) + 1.0f); B4[bj][n] = *(const f32x4*)(shp + c); }
#pragma unroll
        for (int ai = 0; ai < 2; ++ai)
#pragma unroll
            for (int m = 0; m < 4; ++m) { const int rl = ai * HALF + wr * 64 + m * 16 + fr; const float r = S[rl]; bf16_t* up = U + (size_t)(u.pm * BM + rl) * DM + col0;
#pragma unroll
                for (int bj = 0; bj < 2; ++bj) { const f32x4 y0 = acc[ai][bj][m][0] * r * A4[bj][0] + B4[bj][0], y1 = acc[ai][bj][m][1] * r * A4[bj][1] + B4[bj][1];
                    u32x4 w; w.x = cvtpk(y0[0], y0[1]); w.y = cvtpk(y0[2], y0[3]); w.z = cvtpk(y1[0], y1[1]); w.w = cvtpk(y1[2], y1[3]);
                    *(u32x4*)(up + bj * HALF) = w; } }
    }
};
struct EpiCmp {
    static constexpr bool PERM = true;
    float* O;
    __device__ __forceinline__ void operator()(const f32x4 (&acc)[2][2][4][2], const Unit& u, int wr, int wc, int fr, int fq) const {
        const bool isv = u.pm >= 16; const int row0 = u.pm * BM + wr * 64 + fr, col0 = wc * 32 + 8 * fq;
        float* ob = O + (size_t)u.pn * 8192 * 128;
#pragma unroll
        for (int ai = 0; ai < 2; ++ai)
#pragma unroll
            for (int m = 0; m < 4; ++m) { float* rowp = ob + (size_t)(row0 + ai * HALF + m * 16) * 128 + col0;
                *(f32x4*)rowp = isv ? acc[ai][1][m][0] : acc[ai][0][m][0]; *(f32x4*)(rowp + 4) = isv ? acc[ai][1][m][1] : acc[ai][0][m][1]; }
    }
};

template <class Epi>
__device__ __forceinline__ void gemm_phase(LAS unsigned char* lds, const Gemm g, const StaticOrder& S, const Epi& E) {
    int tid_ = threadIdx.x; asm volatile("" : "+v"(tid_));
    const int tid = tid_, wid = __builtin_amdgcn_readfirstlane(tid >> 6), lane = tid & 63, wr = wid >> 2, wc = wid & 3, fr = lane & 15, fq = lane >> 4;
    const int K = g.K, nt = K / BK;
    unsigned voffA[2], voffB[2];
#pragma unroll
    for (int i = 0; i < 2; ++i) { int R, C; stage_rc(tid * 16 + i * 8192, R, C); const int Rb = Epi::PERM ? ((R & ~31) + perm32(R & 31)) : R;
        voffA[i] = (unsigned)(R * g.lda + C) * 2u; voffB[i] = (unsigned)(Rb * g.ldb + C) * 2u; }
    const size_t kstep = (size_t)(BK * 2);
    const size_t hstepA = (size_t)HALF * g.lda * 2, hstepB = (size_t)HALF * g.ldb * 2;
    const size_t tstepA = 2 * hstepA, tstepB = 2 * hstepB;
    const unsigned ldsw = (unsigned)wid * 1024u;
    const int aoff = lds_byte(wr * 64 + fr, fq * 8), boff = lds_byte(wc * 32 + fr, fq * 8);
#define PG8_SA(b, h) (((b) * 2 + (h)) * HTB)
#define PG8_SB(b, h) ((4 + (b) * 2 + (h)) * HTB)
#define PG8_STAGE(bufoff, gbase, voff) do { _Pragma("unroll") for (int _i = 0; _i < 2; ++_i) \
        __builtin_amdgcn_global_load_lds((const unsigned*)((const char*)(gbase) + (voff)[_i]), (LAS unsigned*)(lds + (bufoff) + ldsw + _i * 8192), 16, 0, 0); } while (0)
#define PG8_LDA(dst, b, h) do { _Pragma("unroll") for (int m = 0; m < 4; ++m) _Pragma("unroll") for (int k = 0; k < 2; ++k) dst[m][k] = *(const LAS bf16x8*)(lds + PG8_SA(b, h) + aoff + m * 2048 + k * 1024); } while (0)
#define PG8_LDB(dst, b, h) do { _Pragma("unroll") for (int n = 0; n < 2; ++n) _Pragma("unroll") for (int k = 0; k < 2; ++k) dst[n][k] = *(const LAS bf16x8*)(lds + PG8_SB(b, h) + boff + n * 2048 + k * 1024); } while (0)
#define PG8_MMA(ai, bj, At, Bt) do { __builtin_amdgcn_s_setprio(1); _Pragma("unroll") for (int m = 0; m < 4; ++m) _Pragma("unroll") for (int n = 0; n < 2; ++n) _Pragma("unroll") for (int k = 0; k < 2; ++k) \
        acc[ai][bj][m][n] = __builtin_amdgcn_mfma_f32_16x16x32_bf16(Bt[n][k], At[m][k], acc[ai][bj][m][n], 0, 0, 0); __builtin_amdgcn_s_setprio(0); } while (0)
#define PG8_WAIT_V(n) asm volatile("s_waitcnt vmcnt(" #n ")" ::: "memory")
#define PG8_WAIT_L(n) asm volatile("s_waitcnt lgkmcnt(" #n ")" ::: "memory")
#define PG8_BAR __builtin_amdgcn_s_barrier()
#define PG8_SCHED __builtin_amdgcn_sched_barrier(0)
    Unit cur, nxt; int ui = 0;
    if (!S.next(0, cur)) return;
    f32x4 acc[2][2][4][2];
#pragma unroll
    for (int a = 0; a < 2; ++a)
#pragma unroll
        for (int b = 0; b < 2; ++b)
#pragma unroll
            for (int m = 0; m < 4; ++m)
#pragma unroll
                for (int n = 0; n < 2; ++n) acc[a][b][m][n] = (f32x4){0.f, 0.f, 0.f, 0.f};
    bf16x8 At[4][2], B0[2][2], B1[2][2];
    const size_t ksb = (size_t)g.ksb, bstep = g.ksb ? ksb : tstepB;
    const char* cA = (const char*)g.A + (size_t)cur.pm * tstepA + (size_t)cur.pn * ksb; const char* cB = (const char*)g.Bt + (size_t)cur.pn * bstep;
    PG8_STAGE(PG8_SB(0, 0), cB, voffB); PG8_STAGE(PG8_SB(0, 1), cB + hstepB, voffB); PG8_STAGE(PG8_SA(0, 0), cA, voffA); PG8_STAGE(PG8_SA(0, 1), cA + hstepA, voffA);
    if (wr == 1) PG8_BAR;
    PG8_WAIT_V(2); PG8_BAR;
    PG8_STAGE(PG8_SB(1, 0), cB + kstep, voffB); PG8_STAGE(PG8_SA(1, 0), cA + kstep, voffA); PG8_STAGE(PG8_SB(1, 1), cB + hstepB + kstep, voffB);
    PG8_WAIT_V(6); PG8_BAR;
    for (;;) {
        const bool has_next = S.next(ui + 1, nxt);
        const char* nA = has_next ? (const char*)g.A + (size_t)nxt.pm * tstepA + (size_t)nxt.pn * ksb : cA; const char* nB = has_next ? (const char*)g.Bt + (size_t)nxt.pn * bstep : cB;
        for (int t = 0; t < nt; t += 2) {
            const bool last = (t == nt - 2);
            const char* a1 = cA + (size_t)(t + 1) * kstep;
            const char* a2 = last ? nA : cA + (size_t)(t + 2) * kstep; const char* b2 = last ? nB : cB + (size_t)(t + 2) * kstep;
            const char* a3 = a2 + kstep; const char* b3 = b2 + kstep;
            PG8_LDB(B0, 0, 0); PG8_LDB(B1, 0, 1); PG8_SCHED; PG8_LDA(At, 0, 0); PG8_STAGE(PG8_SA(1, 1), a1 + hstepA, voffA);
            PG8_WAIT_V(8); PG8_WAIT_L(0); PG8_BAR; PG8_MMA(0, 0, At, B0); PG8_MMA(0, 1, At, B1); PG8_BAR; PG8_SCHED;
            PG8_LDA(At, 0, 1); PG8_STAGE(PG8_SB(0, 0), b2, voffB); PG8_STAGE(PG8_SB(0, 1), b2 + hstepB, voffB); PG8_STAGE(PG8_SA(0, 0), a2, voffA);
            PG8_WAIT_V(8); PG8_WAIT_L(0); PG8_BAR; PG8_MMA(1, 0, At, B0); PG8_MMA(1, 1, At, B1); PG8_BAR; PG8_SCHED;
            PG8_LDB(B0, 1, 0); PG8_LDB(B1, 1, 1); PG8_SCHED; PG8_LDA(At, 1, 0); PG8_STAGE(PG8_SA(0, 1), a2 + hstepA, voffA);
            PG8_WAIT_V(8); PG8_WAIT_L(0); PG8_BAR; PG8_MMA(0, 0, At, B0); PG8_MMA(0, 1, At, B1); PG8_BAR; PG8_SCHED;
            PG8_LDA(At, 1, 1); PG8_STAGE(PG8_SB(1, 0), b3, voffB); PG8_STAGE(PG8_SB(1, 1), b3 + hstepB, voffB); PG8_STAGE(PG8_SA(1, 0), a3, voffA);
            PG8_WAIT_V(8); PG8_WAIT_L(0); PG8_BAR; PG8_MMA(1, 0, At, B0); PG8_MMA(1, 1, At, B1); PG8_BAR; PG8_SCHED;
        }
        if (wr == 0) PG8_BAR;
        E(acc, cur, wr, wc, fr, fq);
        if (!has_next) break;
#pragma unroll
        for (int a = 0; a < 2; ++a)
#pragma unroll
            for (int b = 0; b < 2; ++b)
#pragma unroll
                for (int m = 0; m < 4; ++m)
#pragma unroll
                    for (int n = 0; n < 2; ++n) acc[a][b][m][n] = (f32x4){0.f, 0.f, 0.f, 0.f};
        cur = nxt; cA = nA; cB = nB; ++ui;
        if (wr == 1) PG8_BAR;
    }
    PG8_WAIT_V(0);
    PG8_BAR;
#undef PG8_SA
#undef PG8_SB
#undef PG8_STAGE
#undef PG8_LDA
#undef PG8_LDB
#undef PG8_MMA
#undef PG8_WAIT_V
#undef PG8_WAIT_L
#undef PG8_BAR
#undef PG8_SCHED
}
}

#define XB_TMO      128
#define XB_XCNT(j)  (256  + 64 * (j))
#define XB_XSUB(j)  (1280 + 64 * (j))
#define XB_XGEN(j)  (2304 + 64 * (j))
#define XB_TOP      3328
#define XB_TOPGEN   3392
#define XCD_BAR_WORDS 3456
#define XB_SPIN_CAP (1u << 18)
__device__ __forceinline__ unsigned xb_ld(unsigned* p)              { return __hip_atomic_load(p, __ATOMIC_RELAXED, __HIP_MEMORY_SCOPE_AGENT); }
__device__ __forceinline__ unsigned xb_add(unsigned* p, unsigned v) { return __hip_atomic_fetch_add(p, v, __ATOMIC_RELAXED, __HIP_MEMORY_SCOPE_AGENT); }
__device__ __forceinline__ unsigned xb_xcc_id() { return (unsigned)__builtin_amdgcn_s_getreg((3 << 11) | 20) & 0xFu; }
#define XB_SPIN(cond, bar) do { unsigned _sp = 0; while (cond) { __builtin_amdgcn_s_sleep(1); \
    if ((++_sp & 255u) == 0u) { if (xb_ld(&(bar)[XB_TMO])) break; if (_sp > XB_SPIN_CAP) { atomicAdd(&(bar)[XB_TMO], 1u); break; } } } } while (0)
struct XcdBarrier { unsigned* bar; unsigned x; volatile LAS unsigned* st; };
__device__ __forceinline__ XcdBarrier xcd_barrier_post(unsigned* bar, volatile LAS unsigned* st) {
    XcdBarrier b; b.bar = bar; b.x = xb_xcc_id(); b.st = st;
    if (threadIdx.x == 0) (void)xb_add(&bar[XB_XCNT(b.x)], 1u);
    return b;
}
__device__ __forceinline__ void xcd_barrier_complete(unsigned* bar, unsigned x, unsigned& nloc, unsigned& nx) {
    const unsigned G = gridDim.x * gridDim.y * gridDim.z;
    unsigned sum, cnt, mine, sp = 0u;
    for (;;) {
        sum = 0u; cnt = 0u; mine = 0u;
#pragma unroll
        for (unsigned j = 0; j < 16; ++j) { const unsigned c = xb_ld(&bar[XB_XCNT(j)]); sum += c; cnt += (c > 0u) ? 1u : 0u; mine = (j == x) ? c : mine; }
        if (sum == G) break;
        __builtin_amdgcn_s_sleep(1);
        if ((++sp & 255u) == 0u) { if (xb_ld(&bar[XB_TMO])) break; if (sp > XB_SPIN_CAP) { atomicAdd(&bar[XB_TMO], 1u); break; } }
    }
    nloc = mine > 0u ? mine : 1u; nx = cnt > 0u ? cnt : 1u;
}
__device__ __forceinline__ void xcd_barrier(const XcdBarrier& b) {
    asm volatile("s_waitcnt vmcnt(0)" ::: "memory");
    __syncthreads();
    if (threadIdx.x == 0) {
        unsigned* bar = b.bar;
        __builtin_amdgcn_s_waitcnt(0);
        unsigned nloc = b.st[0], nx = b.st[1];
        if (nloc == 0u) { xcd_barrier_complete(bar, b.x, nloc, nx); b.st[0] = nloc; b.st[1] = nx; }
        const unsigned old = xb_add(&bar[XB_XSUB(b.x)], 1u);
        const unsigned gen = old / nloc;
        if (old + 1u == (gen + 1u) * nloc) {
            __builtin_amdgcn_fence(__ATOMIC_RELEASE, "agent");
            asm volatile("s_waitcnt vmcnt(0)" ::: "memory");
            const unsigned og = xb_add(&bar[XB_TOP], 1u);
            const unsigned tg = og / nx;
            if (og + 1u == (tg + 1u) * nx) xb_add(&bar[XB_TOPGEN], 1u);
            else XB_SPIN(xb_ld(&bar[XB_TOPGEN]) == tg, bar);
            __builtin_amdgcn_fence(__ATOMIC_ACQUIRE, "agent");
            xb_add(&bar[XB_XGEN(b.x)], 1u);
            asm volatile("s_waitcnt vmcnt(0)" ::: "memory");
        } else {
            XB_SPIN(xb_ld(&bar[XB_XGEN(b.x)]) == gen, bar);
            __builtin_amdgcn_fence(__ATOMIC_ACQUIRE, "agent");
            asm volatile("s_waitcnt vmcnt(0)" ::: "memory");
        }
    }
    __syncthreads();
}

struct Params {
    const float* x; const float* c; const int* pos; const float* ada_w; const float* ada_b; const float* norm_g;
    const float* ffn_w_in; const float* ffn_w_out; const float* w_in; const float* w_out; const float* a_sinks; const float* a_qk_g;
    const float* b_q_lat_g; const float* b_kv_lat_g; const float* b_w_uq; const float* b_w_ukv; const float* b_qk_nope_g; const float* b_qk_rope_g;
    const float* c_qk_g; const float* c_cmp_pe; const float* c_cmp_w1; const float* c_cmp_w2; const float* c_gate_w; const float* c_gate_b;
    float* out; unsigned char* ws; int ph_lo, ph_hi;
};

__device__ __forceinline__ void transpose_item(const float* __restrict__ W, int Nsrc, int src_col0, bf16_t* WT, int K, int dst_row0, int k0, LAS float* scr, int lane, int nvalid = 32) {
    f32x4 v[8];
    if (src_col0 >= 0 && 4 * (lane & 7) < nvalid) {
        const float* wp = W + (size_t)(k0 + (lane >> 3)) * Nsrc + src_col0 + 4 * (lane & 7);
#pragma unroll
        for (int i = 0; i < 8; ++i) v[i] = *(const f32x4*)(wp + (size_t)(8 * i) * Nsrc);
    } else {
#pragma unroll
        for (int i = 0; i < 8; ++i) v[i] = (f32x4){0.f, 0.f, 0.f, 0.f};
    }
#pragma unroll
    for (int i = 0; i < 8; ++i) { LAS float* d = scr + (8 * i + (lane >> 3)) * 33 + 4 * (lane & 7); d[0] = v[i].x; d[1] = v[i].y; d[2] = v[i].z; d[3] = v[i].w; }
    LDS_WAIT();
    const int c = lane & 7;
#pragma unroll
    for (int j = 0; j < 4; ++j) { const int n = (lane >> 3) + 8 * j; const LAS float* s = scr + (8 * c) * 33 + n;
        u32x4 o; o.x = pk2(s[0 * 33], s[1 * 33]); o.y = pk2(s[2 * 33], s[3 * 33]); o.z = pk2(s[4 * 33], s[5 * 33]); o.w = pk2(s[6 * 33], s[7 * 33]);
        *(u32x4*)(WT + (size_t)(dst_row0 + n) * K + k0 + 8 * c) = o; }
    LDS_WAIT();
}
__device__ __forceinline__ int win_src_col(int c) {
    if (c < 512) return c;
    if (c < 1024) return 928 + (c - 512);
    if (c < 1792) return 1440 + (c - 1024);
    if (c < 2048) return 512 + (c - 1792);
    if (c < 2176) return 768 + (c - 2048);
    if (c < 2208) return 896 + (c - 2176);
    if (c < 2272) return 2208 + (c - 2208);
    return -1;
}
__device__ __forceinline__ void prologue(const Params& p, LAS unsigned char* lds, int tid, int wave, int lane, int G) {
    unsigned char* ws = p.ws;
    {
        LAS float* scr = (LAS float*)(lds + wave * 8448);
        const int gw = blockIdx.x * NWAVES + wave, NGW = G * NWAVES;
        constexpr int I1 = 8 * 16 * 176, I2 = 8 * 44 * 32, I3 = 4 * 16 * 72, I4 = 4 * 16 * 32, I5 = 4 * 4 * 16, I6 = 4 * 2 * 16, I7 = 8 * 32 * 4;
        constexpr int NITEMS = I1 + I2 + I3 + I4 + I5 + I6 + I7;
        for (int it = gw; it < NITEMS; it += NGW) {
            int r = it;
            if (r < I1) { const int m = r / 2816, q = r % 2816, kb = q / 176, nb = q % 176, pn = nb >> 3, wi = nb & 7;
                const int src = wi < 4 ? 128 * pn + 32 * wi : DFF + 128 * pn + 32 * (wi - 4);
                transpose_item(p.ffn_w_in + (size_t)m * DM * 2 * DFF, 2 * DFF, src, (bf16_t*)(ws + WS_W1T) + (size_t)m * 2 * DFF * DM, DM, nb * 32, kb * 64, scr, lane); continue; }
            r -= I1;
            if (r < I2) { const int m = r / 1408, q = r % 1408, kb = q / 32, nb = q % 32;
                transpose_item(p.ffn_w_out + (size_t)m * DFF * DM, DM, nb * 32, (bf16_t*)(ws + WS_W2T) + (size_t)m * DM * DFF, DFF, nb * 32, kb * 64, scr, lane); continue; }
            r -= I2;
            if (r < I3) { const int m = r / 1152, q = r % 1152, kb = q / 72, nb = q % 72;
                transpose_item(p.w_in + (size_t)m * DM * DIN, DIN, win_src_col(nb < 56 ? (nb >> 3) * 256 + 64 * (nb & 3) + 32 * ((nb >> 2) & 1) : nb * 32),     (bf16_t*)(ws + WS_WINT) + (size_t)m * DINP * DM, DM, nb * 32, kb * 64, scr, lane); continue; }
            r -= I3;
            if (r < I4) { const int m = r / 512, q = r % 512, kb = q / 32, nb = q % 32;
                transpose_item(p.w_out + (size_t)m * DM * DM, DM, nb * 32, (bf16_t*)(ws + WS_WOUTT) + (size_t)m * DM * DM, DM, nb * 32, kb * 64, scr, lane); continue; }
            r -= I4;
            if (r < I5) { const int m = r / 64, q = r % 64, kb = q / 16, nb = q % 16;
                transpose_item(p.b_w_uq + (size_t)m * 256 * 384, 384, nb < 8 ? 96 * (nb & 3) + 32 * (nb >> 2) : 96 * (nb & 3) + 64 + 16 * ((nb - 8) >> 2), (bf16_t*)(ws + WS_WUQT) + (size_t)m * 512 * 256, 256, nb * 32, kb * 64, scr, lane, nb < 8 ? 32 : 16); continue; }
            r -= I5;
            if (r < I6) { const int m = r / 32, q = r % 32, kb = q / 16, nb = q % 16;
                transpose_item(p.b_w_ukv + (size_t)m * 128 * 512, 512, 128 * (2 * (nb >> 3) + ((nb & 3) >> 1)) + 64 * (nb & 1) + 32 * ((nb >> 2) & 1), (bf16_t*)(ws + WS_WUKVT) + (size_t)m * 512 * 128, 128, nb * 32, kb * 64, scr, lane); continue; }
            r -= I6;
            { const int m = r / 128, q = r % 128, kb = q / 4, nb = q % 4;
                transpose_item(p.c_cmp_w1 + (size_t)m * 2048 * 128, 128, nb * 32, (bf16_t*)(ws + WS_WC1T) + (size_t)(m >> 1) * 256 * 2048, 2048, (m & 1) * 128 + nb * 32, kb * 64, scr, lane); }
        }
    }
    __syncthreads();
    {
        LAS float* cond = (LAS float*)lds;
        LAS float* red = (LAS float*)(lds + 32768);
        for (int i = tid; i < NBATCH * DM; i += NTHREADS) { const float cv = p.c[i]; cond[i] = cv / (1.0f + __expf(-cv)); }
        __syncthreads();
        const int col = tid & 63, ks = tid >> 6;
        float* MOD = (float*)(ws + WS_MOD);
        LAS float* red2 = (LAS float*)(lds + 32768);
        const int c4 = tid & 15, k32 = tid >> 4;
        for (int unit = blockIdx.x; unit < DEPTH * 144; unit += G) {
            const int l = unit / 144, n0 = (unit % 144) * 64;
            const float* Wp = p.ada_w + (size_t)l * DM * (NMOD * DM) + n0 + 4 * c4;
            f32x4 acc[8];
#pragma unroll
            for (int r = 0; r < 8; ++r) acc[r] = (f32x4){0.f, 0.f, 0.f, 0.f};
#pragma unroll 8
            for (int k = k32 * 32; k < k32 * 32 + 32; ++k) { const f32x4 w = *(const f32x4*)(Wp + (size_t)k * (NMOD * DM));
#pragma unroll
                for (int r = 0; r < 8; ++r) acc[r] += w * cond[r * DM + k]; }
#pragma unroll
            for (int r = 0; r < 8; ++r) { LAS float* d = red2 + (k32 * 8 + r) * 64 + 4 * c4; d[0] = acc[r].x; d[1] = acc[r].y; d[2] = acc[r].z; d[3] = acc[r].w; }
            __syncthreads();
            { const int r = tid >> 6; float v = 0.f;
#pragma unroll
              for (int k2 = 0; k2 < 32; ++k2) v += red2[(k2 * 8 + r) * 64 + col];
              MOD[((size_t)l * NBATCH + r) * (NMOD * DM) + n0 + col] = v + p.ada_b[(size_t)l * (NMOD * DM) + n0 + col]; }
            __syncthreads();
        }
        float* CMPBP = (float*)(ws + WS_CMPBP);
        for (int unit = (int)((blockIdx.x + G / 2) % G); unit < 256; unit += G) {
            const int m = unit >> 5, sl = unit & 31, cc = tid & 127, kq = tid >> 7;
            const float* pe = p.c_cmp_pe + (size_t)m * 2048 + sl * 64 + kq * 16; const float* w1 = p.c_cmp_w1 + ((size_t)m * 2048 + sl * 64 + kq * 16) * 128 + cc;
            float a = 0.f;
#pragma unroll
            for (int k = 0; k < 16; ++k) a += pe[k] * w1[(size_t)k * 128];
            red[kq * 128 + cc] = a;
            __syncthreads();
            if (tid < 128) CMPBP[(size_t)unit * 128 + tid] = (red[tid] + red[128 + tid]) + (red[256 + tid] + red[384 + tid]);
            __syncthreads();
        }
    }
    {
        float* C64 = (float*)(ws + WS_COS64); float* S64 = (float*)(ws + WS_SIN64); float* C32 = (float*)(ws + WS_COS32); float* S32 = (float*)(ws + WS_SIN32);
        for (int idx = blockIdx.x * NTHREADS + tid; idx < T * 32; idx += G * NTHREADS) {
            const int tok = idx >> 5, i = idx & 31; const float posf = (float)p.pos[tok];
            { const float inv = 1.0f / powf(10000.0f, (float)(2 * i) / 64.0f); const float ang = posf * inv;
              double rev = (double)ang * 0.15915494309189535; rev -= rint(rev); const float rr = (float)(rev * 6.283185307179586);
              C64[idx] = cosf(rr); S64[idx] = sinf(rr); }
            if (i < 16) { const float inv = 1.0f / powf(10000.0f, (float)(2 * i) / 32.0f); const float ang = posf * inv;
              double rev = (double)ang * 0.15915494309189535; rev -= rint(rev); const float rr = (float)(rev * 6.283185307179586);
              C32[tok * 16 + i] = cosf(rr); S32[tok * 16 + i] = sinf(rr); }
        }
        if (blockIdx.x == 0) { unsigned* z = (unsigned*)(ws + WS_R2 + R2_ZV + 8 * MiB); for (int i = tid; i < 4096; i += NTHREADS) z[i] = 0u; }
    }
}

__device__ __forceinline__ void norm_phase(const float* hin, bf16_t* U, const float* g, const float* modl, int sc_i, int sh_i, int gw, int ngw, int lane) {
    const int b = gw & 7, r0 = gw >> 3, rs = ngw >> 3;
    const float* scp = modl + (size_t)b * (NMOD * DM) + sc_i * DM; const float* shp = modl + (size_t)b * (NMOD * DM) + sh_i * DM;
    f32x4 A[4], B[4];
#pragma unroll
    for (int j = 0; j < 4; ++j) { const int col = 4 * lane + 256 * j; A[j] = *(const f32x4*)(g + col) * (*(const f32x4*)(scp + col) + 1.0f); B[j] = *(const f32x4*)(shp + col); }
    f32x4 v[4], nv[4], mv[4];
    if (r0 < SEQ) { const f32x4* xr = (const f32x4*)(hin + (size_t)(b * SEQ + r0) * DM) + lane;
#pragma unroll
        for (int j = 0; j < 4; ++j) v[j] = xr[64 * j]; }
    if (r0 + rs < SEQ) { const f32x4* xr = (const f32x4*)(hin + (size_t)(b * SEQ + r0 + rs) * DM) + lane;
#pragma unroll
        for (int j = 0; j < 4; ++j) nv[j] = xr[64 * j]; }
    for (int r = r0; r < SEQ; r += rs) {
        const int row = b * SEQ + r;
        if (r + 2 * rs < SEQ) { const f32x4* xr = (const f32x4*)(hin + (size_t)(row + 2 * rs) * DM) + lane;
#pragma unroll
            for (int j = 0; j < 4; ++j) mv[j] = xr[64 * j]; }
        float ss = 0.f;
#pragma unroll
        for (int j = 0; j < 4; ++j) ss += (v[j].x * v[j].x + v[j].y * v[j].y) + (v[j].z * v[j].z + v[j].w * v[j].w);
        const float rr = rsqrtf(wave_sum(ss) * (1.0f / DM) + EPS);
#pragma unroll
        for (int j = 0; j < 4; ++j) { const f32x4 y = (v[j] * rr) * A[j] + B[j];
            u32x2 w; w.x = cvtpk(y.x, y.y); w.y = cvtpk(y.z, y.w);
            *(u32x2*)(U + (size_t)row * DM + 4 * lane + 256 * j) = w; }
#pragma unroll
        for (int j = 0; j < 4; ++j) { v[j] = nv[j]; nv[j] = mv[j]; }
    }
}

__device__ __forceinline__ void unpack4(const u32x2 r, float (&f)[4]) { f[0] = __builtin_bit_cast(float, r.x << 16); f[1] = __builtin_bit_cast(float, r.x & 0xffff0000u); f[2] = __builtin_bit_cast(float, r.y << 16); f[3] = __builtin_bit_cast(float, r.y & 0xffff0000u); }
__device__ __forceinline__ u32x2 pack4(const float (&f)[4]) { u32x2 w; w.x = cvtpk(f[0], f[1]); w.y = cvtpk(f[2], f[3]); return w; }
__device__ __forceinline__ float sumsq8(const float (&a)[4], const float (&b)[4]) { return ((a[0] * a[0] + a[1] * a[1]) + (a[2] * a[2] + a[3] * a[3])) + ((b[0] * b[0] + b[1] * b[1]) + (b[2] * b[2] + b[3] * b[3])); }
__device__ __forceinline__ void load4g(const float* g, float (&o)[4]) { const f32x4 t = *(const f32x4*)g; o[0] = t.x; o[1] = t.y; o[2] = t.z; o[3] = t.w; }
__device__ __forceinline__ void ones4(float (&o)[4]) { o[0] = 1.f; o[1] = 1.f; o[2] = 1.f; o[3] = 1.f; }
__device__ __forceinline__ void scale_rope(float (&a)[4], float (&b)[4], float r, const float (&ga)[4], const float (&gb)[4], bool rope, const f32x4& cs, const f32x4& sn) {
#pragma unroll
    for (int e = 0; e < 4; ++e) { const float ya = a[e] * r * ga[e], yb = b[e] * r * gb[e];
        a[e] = rope ? ya * cs[e] - yb * sn[e] : ya; b[e] = rope ? yb * cs[e] + ya * sn[e] : yb; }
}
__device__ __forceinline__ void postproc_a2(const Params& p, LAS unsigned char* lds, int l, int gw, int ngw, int lane) {
    unsigned char* ws = p.ws; unsigned char* r2 = ws + WS_R2;
    const bf16_t* P2 = (const bf16_t*)(ws + WS_R1);
    bf16_t *CQN = (bf16_t*)(r2 + R2_CQN), *CKVN = (bf16_t*)(r2 + R2_CKVN), *KPE = (bf16_t*)(r2 + R2_KPE);
    float* GATES = (float*)(r2 + R2_GATES);
    const float* C32 = (const float*)(ws + WS_COS32); const float* S32 = (const float*)(ws + WS_SIN32);
    const int j = lane & 7, j4 = lane & 3;
    const int kind = lane < 32 ? 0 : (lane < 48 ? 1 : (lane < 52 ? 2 : (lane < 60 ? 3 : 4)));
    const int offA = kind == 0 ? 64 * (lane >> 3) + 4 * j : (kind == 1 ? 256 + 64 * ((lane - 32) >> 3) + 4 * j : (kind == 2 ? 384 + 4 * j4 : (kind == 3 ? 416 + 8 * (lane - 52) : 480)));
    const int offB = kind <= 1 ? offA + 32 : (kind == 2 ? offA + 16 : offA + 4);
    float ga[4], gb[4];
    if (kind == 0) { const float* gp = p.b_q_lat_g + l * 256 + offA; load4g(gp, ga); load4g(gp + 32, gb); }
    else if (kind == 1) { const float* gp = p.b_kv_lat_g + l * 128 + (offA - 256); load4g(gp, ga); load4g(gp + 32, gb); }
    else if (kind == 2) { const float* gp = p.b_qk_rope_g + (l * 2 + 1) * 32 + 4 * j4; load4g(gp, ga); load4g(gp + 16, gb); }
    else { ones4(ga); ones4(gb); }
    bf16_t* dst = kind == 0 ? CQN + offA : (kind == 1 ? CKVN + (offA - 256) : KPE + 4 * j4); const int ts = kind == 0 ? 256 : (kind == 1 ? 128 : 32), bo = kind == 2 ? 16 : 32;
    const int jj = lane < 24 ? lane : 23;
    LAS float* gwl = (LAS float*)lds;
    __syncthreads();
    { int t_ = threadIdx.x; asm volatile("" : "+v"(t_)); for (int i = t_; i < 64 * 24; i += NTHREADS) gwl[i] = p.c_gate_w[(size_t)l * 64 * 24 + i]; }
    __syncthreads();
    const float gbias = p.c_gate_b[l * 24 + jj];
    u32x2 ra, rb, na, nb;
    if (gw < T) { ra = *(const u32x2*)(P2 + (size_t)gw * 512 + offA); rb = *(const u32x2*)(P2 + (size_t)gw * 512 + offB); }
    for (int tok = gw; tok < T; tok += ngw) {
        if (tok + ngw < T) { na = *(const u32x2*)(P2 + (size_t)(tok + ngw) * 512 + offA); nb = *(const u32x2*)(P2 + (size_t)(tok + ngw) * 512 + offB); }
        const f32x4 cs32 = *(const f32x4*)(C32 + (size_t)tok * 16 + 4 * j4), sn32 = *(const f32x4*)(S32 + (size_t)tok * 16 + 4 * j4);
        float a[4], bb[4];
        unpack4(ra, a); unpack4(rb, bb);
        float ss = sumsq8(a, bb); ss += __shfl_xor(ss, 1); ss += __shfl_xor(ss, 2);
        float s16 = ss; s16 += __shfl_xor(s16, 4); s16 += __shfl_xor(s16, 8);
        float s32 = s16; s32 += __shfl_xor(s32, 16);
        float sg[8];
#pragma unroll
        for (int e = 0; e < 4; ++e) { sg[e] = silu_f(a[e]); sg[4 + e] = silu_f(bb[e]); }
        const float r = kind == 0 ? rsqrtf(s32 * (1.0f / 256) + EPS) : (kind == 1 ? rsqrtf(s16 * (1.0f / 128) + EPS) : rsqrtf(ss * (1.0f / 32) + EPS));
        scale_rope(a, bb, r, ga, gb, kind == 2, cs32, sn32);
        if (kind <= 2) { bf16_t* d = dst + (size_t)tok * ts; *(u32x2*)d = pack4(a); *(u32x2*)(d + bo) = pack4(bb); }
        float acc = gbias;
#pragma unroll
        for (int k = 0; k < 64; ++k) acc += __builtin_bit_cast(float, __builtin_amdgcn_readlane(__builtin_bit_cast(int, sg[k & 7]), 52 + (k >> 3))) * gwl[k * 24 + jj];
        if (lane < 24) GATES[(size_t)tok * 24 + lane] = 1.0f / (1.0f + __expf(-acc));
        ra = na; rb = nb;
    }
}

__device__ __forceinline__ void postproc_b(const Params& p, LAS unsigned char* lds, int l, int gw, int ngw, int lane) {
    unsigned char* ws = p.ws; unsigned char* r1 = ws + WS_R1; unsigned char* r2 = ws + WS_R2;
    bf16_t *KCMP = (bf16_t*)(r2 + R2_KCMP), *VCMP = (bf16_t*)(r2 + R2_VCMP);
    const float* HIDP = (const float*)(r1 + R1_HIDP); const float* CMPB = (const float*)(ws + WS_CMPB);
    const float gck = p.c_qk_g[(l * 4 + 1) * 64 + lane];
    LAS float* w2l = (LAS float*)lds;
    __syncthreads();
    { int t_ = threadIdx.x; asm volatile("" : "+v"(t_)); const f32x4* src = (const f32x4*)(p.c_cmp_w2 + (size_t)l * 2 * 128 * 64);
      for (int i = t_; i < 2 * 128 * 64 / 4; i += NTHREADS) ((LAS f32x4*)w2l)[i] = src[i]; }
    __syncthreads();
    for (int r = gw; r < 8192; r += ngw) {
        const int kv = r >> 12, rr = r & 4095, i = rr & 255;
        const LAS float* w2 = w2l + kv * 128 * 64 + lane;
        float hs0 = CMPB[(l * 2 + kv) * 128 + lane], hs1 = CMPB[(l * 2 + kv) * 128 + 64 + lane];
#pragma unroll
        for (int sl = 0; sl < 4; ++sl) { hs0 += HIDP[((size_t)sl * 8192 + r) * 128 + lane]; hs1 += HIDP[((size_t)sl * 8192 + r) * 128 + 64 + lane]; }
        const int h0 = __builtin_bit_cast(int, bf2f(f2bf(silu_f(hs0)))), h1 = __builtin_bit_cast(int, bf2f(f2bf(silu_f(hs1))));
        float a = 0.f;
#pragma unroll
        for (int k = 0; k < 64; ++k) a += __builtin_bit_cast(float, __builtin_amdgcn_readlane(h0, k)) * w2[k * 64];
#pragma unroll
        for (int k = 0; k < 64; ++k) a += __builtin_bit_cast(float, __builtin_amdgcn_readlane(h1, k)) * w2[(64 + k) * 64];
        if (kv == 0) { float y = a * rsqrtf(wave_sum(a * a) * (1.0f / 64) + EPS) * gck; if (i == 255) y = 0.f; KCMP[(size_t)rr * 64 + lane] = (bf16_t)f2bf(y); }
        else { if (i == 255) a = 0.f; VCMP[(size_t)rr * 64 + lane] = (bf16_t)f2bf(a); }
    }
}

constexpr int AL_K = 0, AL_V = 13312, AL_BUF = 22528, AL_IMP = 4 * 22528, AL_UNI = 4 * 22528 + 33280;
#define MFMA16(a, b, c) __builtin_amdgcn_mfma_f32_16x16x32_bf16((a), (b), (c), 0, 0, 0)

template <int NC>
__device__ __forceinline__ void attn_s_pair(const LAS unsigned char* Ks, const bf16x8 (&q0)[NC], const bf16x8 (&q1)[NC], f32x4 (&s)[2][4], int fr, int fq, float i0 = 0.f, float i1 = 0.f) {
    constexpr int PITCHB = (32 * NC + 8) * 2;
#pragma unroll
    for (int kb = 0; kb < 4; ++kb) {
        s[0][kb] = (f32x4){i0, i0, i0, i0}; s[1][kb] = (f32x4){i1, i1, i1, i1};
#pragma unroll
        for (int c = 0; c < NC; ++c) {
            const bf16x8 kf = *(const LAS bf16x8*)(Ks + (16 * kb + fr) * PITCHB + (32 * c + 8 * fq) * 2);
            s[0][kb] = MFMA16(kf, q0[c], s[0][kb]); s[1][kb] = MFMA16(kf, q1[c], s[1][kb]);
        }
    }
}
typedef short v4i16_t __attribute__((ext_vector_type(4)));
__device__ __forceinline__ bf16x4 vtr_read(const LAS unsigned char* p) { return __builtin_bit_cast(bf16x4, __builtin_amdgcn_ds_read_tr16_b64_v4i16((LAS v4i16_t*)p)); }
__device__ __forceinline__ void attn_pv_pair(const LAS unsigned char* Vs, const bf16x8 (&pf)[2][2], f32x4 (&o0)[4], f32x4 (&o1)[4], int fr, int fq) {
    const LAS unsigned char* vb = Vs + (4 * fq + (fr >> 2)) * 144 + 8 * (fr & 3);
#pragma unroll
    for (int db = 0; db < 4; ++db)
#pragma unroll
        for (int kc = 0; kc < 2; ++kc) {
            const bf16x4 lo = vtr_read(vb + (32 * kc) * 144 + 32 * db), hi = vtr_read(vb + (32 * kc + 16) * 144 + 32 * db);
            const bf16x8 vf = {lo.x, lo.y, lo.z, lo.w, hi.x, hi.y, hi.z, hi.w};
            o0[db] = MFMA16(vf, pf[0][kc], o0[db]); o1[db] = MFMA16(vf, pf[1][kc], o1[db]);
        }
}
__device__ __forceinline__ bf16x8 pack_p(const f32x4& a, const f32x4& b) {
    u32x4 w; w.x = cvtpk(a[0], a[1]); w.y = cvtpk(a[2], a[3]); w.z = cvtpk(b[0], b[1]); w.w = cvtpk(b[2], b[3]); return __builtin_bit_cast(bf16x8, w);
}
template <int NC>
__device__ __forceinline__ void tile_load(const bf16_t* Kb, const bf16_t* Vb, int t, u32x4& k0, u32x4& k1, u32x4& v, int tid, bool withV) {
    const unsigned ko = (unsigned)t * (64u * 32u * NC) + (unsigned)tid * 8u, vo = (unsigned)t * 4096u + (unsigned)tid * 8u;
    k0 = *(const u32x4*)(Kb + ko);
    if (NC == 3) { if (tid < 256) k1 = *(const u32x4*)(Kb + ko + 4096u); }
    if (withV) v = *(const u32x4*)(Vb + vo);
}
template <int NC>
__device__ __forceinline__ void tile_store(LAS unsigned char* lds, const u32x4& k0, const u32x4& k1, const u32x4& v, int tid, bool withV) {
    constexpr int CPK = 4 * NC, PITCHB = (32 * NC + 8) * 2;
    { const int key = tid / CPK, ch = tid % CPK; *(LAS u32x4*)(lds + AL_K + key * PITCHB + ch * 16) = k0; }
    if (NC == 3) { if (tid < 256) { const int cid = tid + 512, key = cid / CPK, ch = cid % CPK; *(LAS u32x4*)(lds + AL_K + key * PITCHB + ch * 16) = k1; } }
    if (withV) { const int key = tid >> 3, ch = tid & 7; *(LAS u32x4*)(lds + AL_V + key * 144 + ch * 16) = v; }
}

struct AttnPtrs { const bf16_t* Q; const bf16_t* K; const bf16_t* V; bf16_t* O; int ldo, col0; float c2, shiftC; const float* sinks; const unsigned long long* sel; const float* gates; const bf16_t* ocmp; const bf16_t* K2; const bf16_t* V2; float shift2; };
template <int MODE> struct ACfg;
template <> struct ACfg<0> { static constexpr int NC = 2, G = 2, H = 4, HKV = 2; };
template <> struct ACfg<1> { static constexpr int NC = 3, G = 1, H = 4, HKV = 4; };
template <> struct ACfg<2> { static constexpr int NC = 2, G = 4, H = 8, HKV = 2; };
template <> struct ACfg<3> { static constexpr int NC = 2, G = 4, H = 8, HKV = 2; };

template <int MODE, int SM>
__device__ __forceinline__ void attn_tile(const LAS unsigned char* Kl, const LAS unsigned char* Vl, const bf16x8 (&qf)[2][ACfg<MODE>::NC], f32x4 (&o)[2][4], f32x4 (&lacc)[2],
                                          int kt, int qw0, int fr, int fq, float shiftC, bool masked, unsigned selbits) {
    constexpr int NC = ACfg<MODE>::NC, G = ACfg<MODE>::G;
    f32x4 s[2][4];
    attn_s_pair<NC>(Kl, qf[0], qf[1], s, fr, fq, (selbits & 1u) ? -shiftC : -INFINITY, (selbits & 2u) ? -shiftC : -INFINITY);
    bf16x8 pf[2][2];
    const u32x4 onesw = {0x3f803f80u, 0x3f803f80u, 0x3f803f80u, 0x3f803f80u}; const bf16x8 ones = __builtin_bit_cast(bf16x8, onesw);
#pragma unroll
    for (int g = 0; g < 2; ++g) {
        if (masked) {
            const int qpos = (MODE == 3) ? qw0 + 4 * g + (fr >> 2) : qw0 + (G == 1 ? 16 * g : 0) + fr;
#pragma unroll
            for (int kb = 0; kb < 4; ++kb)
#pragma unroll
                for (int e = 0; e < 4; ++e) { const int key = 64 * kt + 16 * kb + 4 * fq + e; bool valid;
                    if (SM == 0) valid = (key <= qpos) && (key > qpos - 128);
                    else if (SM == 2) valid = (key <= qpos) && (key > qpos - 256);
                    else valid = key <= qpos;
                    s[g][kb][e] = valid ? s[g][kb][e] : -INFINITY; }
        }
#pragma unroll
        for (int kb = 0; kb < 4; ++kb)
#pragma unroll
            for (int e = 0; e < 4; ++e) s[g][kb][e] = fast_exp2(s[g][kb][e]);
        pf[g][0] = pack_p(s[g][0], s[g][1]); pf[g][1] = pack_p(s[g][2], s[g][3]);
        lacc[g] = MFMA16(ones, pf[g][0], lacc[g]); lacc[g] = MFMA16(ones, pf[g][1], lacc[g]);
    }
    attn_pv_pair(Vl, pf, o[0], o[1], fr, fq);
}

template <int MODE, int SM>
__device__ __forceinline__ void attn_stream(LAS unsigned char* lds, const bf16_t* Kb, const bf16_t* Vb, const bf16x8 (&qf)[2][ACfg<MODE>::NC], f32x4 (&o)[2][4], f32x4 (&lacc)[2],
                                            const unsigned long long* selp, int q0, int qw0, int qt, float sh_loc, int tid, int w, int lane, int fr, int fq) {
    typedef ACfg<MODE> C; constexpr int NC = C::NC, G = C::G;
    constexpr int QW = (MODE == 3) ? 8 : ((G == 1) ? 32 : 16), UQ = (G == 1) ? 256 : (G == 2 ? 128 : 64);
    int kt_lo = 0, kt_hi = 0; unsigned long long rem = 0ull, wuni = 0ull; unsigned s0lo = 0u, s0hi = 0u, s1lo = 0u, s1hi = 0u;
    if (SM == 0) { kt_lo = (q0 - 127) < 0 ? 0 : (q0 - 127) >> 6; kt_hi = (q0 + UQ - 1) >> 6; }
    if (SM == 1) { kt_lo = 0; kt_hi = (q0 + UQ - 1) >> 6; }
    if (SM == 2) { kt_lo = (q0 - 255) < 0 ? 0 : (q0 - 255) >> 6; kt_hi = (q0 + UQ - 1) >> 6; }
    __syncthreads();
    if (SM == 3) {
        const unsigned long long sel = selp[qw0 + (fr >> 2)], sel1 = selp[qw0 + 4 + (fr >> 2)];
        s0lo = (unsigned)sel; s0hi = (unsigned)(sel >> 32); s1lo = (unsigned)sel1; s1hi = (unsigned)(sel1 >> 32);
        unsigned lo = s0lo | s1lo, hi = s0hi | s1hi;
#pragma unroll
        for (int off = 4; off < 16; off <<= 1) { lo |= __shfl_xor(lo, off); hi |= __shfl_xor(hi, off); }
        wuni = ((unsigned long long)(unsigned)__builtin_amdgcn_readfirstlane((int)hi) << 32) | (unsigned)__builtin_amdgcn_readfirstlane((int)lo);
        LAS unsigned* un = (LAS unsigned*)(lds + AL_UNI);
        if (lane == 0) { un[2 * w] = lo; un[2 * w + 1] = hi; }
        __syncthreads();
        unsigned ulo = 0, uhi = 0;
#pragma unroll
        for (int j = 0; j < 8; ++j) { ulo |= un[2 * j]; uhi |= un[2 * j + 1]; }
        rem = ((unsigned long long)(unsigned)__builtin_amdgcn_readfirstlane((int)uhi) << 32) | (unsigned)__builtin_amdgcn_readfirstlane((int)ulo);
    }
#define NEXT_TILE(dst, cur) do { if (SM == 3) { dst = rem ? (int)__builtin_ctzll(rem) : -1; rem &= rem - 1; } else dst = ((cur) >= 0 && (cur) < kt_hi) ? (cur) + 1 : -1; } while (0)
#define TILE_LOAD(t, K0, K1, V0) tile_load<NC>(Kb, Vb, (t), K0, K1, V0, tid, true)
#define TILE_COMPUTE(t, bufoff) do { \
        bool need_, full_; \
        if (SM == 0) { need_ = (64 * (t) + 63 > qw0 - 128) && (64 * (t) <= qw0 + QW - 1); full_ = (64 * (t) + 63 <= qw0) && (64 * (t) > qw0 + QW - 1 - 128); } \
        else if (SM == 1) { need_ = 64 * (t) <= qw0 + QW - 1; full_ = 64 * (t) + 63 <= qw0; } \
        else if (SM == 2) { need_ = (64 * (t) + 63 > qw0 - 256) && (64 * (t) <= qw0 + QW - 1); full_ = (64 * (t) + 63 <= qw0) && (64 * (t) > qw0 + QW - 1 - 256); } \
        else { need_ = ((wuni >> (t)) & 1ull) != 0ull; full_ = (t) != qt; }     \
        if (need_) { const unsigned selbit_ = (SM == 3) ? ((((((t) & 32) ? s0hi : s0lo) >> ((t) & 31)) & 1u) | ((((((t) & 32) ? s1hi : s1lo) >> ((t) & 31)) & 1u) << 1)) : 3u; \
            if (full_) attn_tile<MODE, SM>(lds + (bufoff) + AL_K, lds + (bufoff) + AL_V, qf, o, lacc, (t), qw0, fr, fq, sh_loc, false, selbit_); \
            else attn_tile<MODE, SM>(lds + (bufoff) + AL_K, lds + (bufoff) + AL_V, qf, o, lacc, (t), qw0, fr, fq, sh_loc, true, selbit_); } } while (0)
    int tq[6];
    if (SM == 3) { tq[0] = rem ? (int)__builtin_ctzll(rem) : -1; rem &= rem - 1; } else tq[0] = kt_lo;
#pragma unroll
    for (int k = 1; k < 4; ++k) NEXT_TILE(tq[k], tq[k - 1]);
    u32x4 rk0[2], rk1[2], rv[2];
    rk1[0] = (u32x4){0u, 0u, 0u, 0u}; rk1[1] = rk1[0];
#define LOADSET(u, t) do { const int tl_ = (t) < 0 ? 0 : (t); TILE_LOAD(tl_, rk0[u], rk1[u], rv[u]); } while (0)
    if (tq[0] >= 0) {
        LOADSET(0, tq[0]); LOADSET(1, tq[1]);
        tile_store<NC>(lds, rk0[0], rk1[0], rv[0], tid, true); tile_store<NC>(lds + AL_BUF, rk0[1], rk1[1], rv[1], tid, true);
        LOADSET(0, tq[2]); LOADSET(1, tq[3]);
        __syncthreads();
        for (;;) {
#pragma unroll
            for (int u = 0; u < 2; ++u) {
                const int cur = u ? 2 * AL_BUF : 0, nxt = u ? 0 : 2 * AL_BUF;
                tile_store<NC>(lds + nxt, rk0[0], rk1[0], rv[0], tid, true); tile_store<NC>(lds + nxt + AL_BUF, rk0[1], rk1[1], rv[1], tid, true);
                NEXT_TILE(tq[4], tq[3]); NEXT_TILE(tq[5], tq[4]);
                LOADSET(0, tq[4]); LOADSET(1, tq[5]);
                TILE_COMPUTE(tq[0], cur);
                if (tq[1] >= 0) TILE_COMPUTE(tq[1], cur + AL_BUF);
                __syncthreads();
#pragma unroll
                for (int k = 0; k < 4; ++k) tq[k] = tq[k + 2];
                if (tq[0] < 0) break;
            }
            if (tq[0] < 0) break;
        }
    }
#undef LOADSET
#undef NEXT_TILE
#undef TILE_LOAD
#undef TILE_COMPUTE
}

template <int MODE>
__device__ __forceinline__ void attn_flash(LAS unsigned char* lds, const AttnPtrs& a, int b, int hkv, int qt) {
    typedef ACfg<MODE> C; constexpr int NC = C::NC, G = C::G, DQ = 32 * NC;
    constexpr int QW = (G == 1) ? 32 : 16, UQ = (G == 1) ? 256 : (G == 2 ? 128 : 64);
    const float sh_loc = uniform_f(a.shiftC), sh2_loc = uniform_f(a.shift2); const int ldo_loc = __builtin_amdgcn_readfirstlane(a.ldo), col0_loc = __builtin_amdgcn_readfirstlane(a.col0);
    int tid_ = threadIdx.x; asm volatile("" : "+v"(tid_));
    const int tid = tid_, w = __builtin_amdgcn_readfirstlane(tid >> 6), lane = tid & 63, fr = lane & 15, fq = lane >> 4;
    const int q0 = qt * UQ, qw0 = q0 + (MODE == 3 ? 8 * w : QW * w);
    const int hbase = hkv * G;
    bf16x8 qf[2][NC];
#pragma unroll
    for (int i = 0; i < 2; ++i) { const int h = (MODE == 3) ? hkv * 4 + (fr & 3) : hbase + (G == 1 ? 0 : i), q = (MODE == 3) ? qw0 + 4 * i + (fr >> 2) : qw0 + (G == 1 ? 16 * i : 0) + fr;
        const bf16_t* qp = a.Q + ((size_t)(b * C::H + h) * SEQ + q) * DQ + 8 * fq;
#pragma unroll
        for (int c = 0; c < NC; ++c) qf[i][c] = *(const bf16x8*)(qp + 32 * c); }
    f32x4 o[2][4], lacc[2], ow[2][4], lw[2];
#pragma unroll
    for (int i = 0; i < 2; ++i) { lacc[i] = (f32x4){0.f, 0.f, 0.f, 0.f}; lw[i] = lacc[i];
#pragma unroll
        for (int d = 0; d < 4; ++d) { o[i][d] = (f32x4){0.f, 0.f, 0.f, 0.f}; ow[i][d] = o[i][d]; } }
    const size_t kvo = (size_t)(b * C::HKV + hkv) * SEQ;
    if (MODE == 3) attn_stream<MODE, 2>(lds, a.K2 + kvo * DQ, a.V2 + kvo * 64, qf, ow, lw, nullptr, q0, qw0, qt, sh2_loc, tid, w, lane, fr, fq);
    attn_stream<MODE, MODE>(lds, a.K + kvo * DQ, a.V + kvo * 64, qf, o, lacc, MODE == 3 ? a.sel + (size_t)(b * 2 + hkv) * SEQ : nullptr, q0, qw0, qt, sh_loc, tid, w, lane, fr, fq);
#pragma unroll
    for (int i = 0; i < 2; ++i) {
        const int hl = (MODE == 3) ? hkv * 4 + (fr & 3) : hbase + (G == 1 ? 0 : i), q = (MODE == 3) ? qw0 + 4 * i + (fr >> 2) : qw0 + (G == 1 ? 16 * i : 0) + fr;
        float lt = lacc[i][0];
        if (MODE == 0) { const float* sp_ = a.sinks; asm volatile("" : "+s"(sp_)); lt += fast_exp2(sp_[hl] * LOG2E - sh_loc); }
        const float inv = lt > 0.f ? 1.0f / lt : 0.f;
        const size_t tok = (size_t)b * SEQ + q;
        float g0 = 0.f, g1 = 0.f, g2 = 0.f;
        if (MODE == 3) { const float* gp = a.gates + tok * 24 + 3 * hl; const float lwv = lw[i][0]; g0 = gp[0]; g1 = gp[1] * inv; g2 = lwv > 0.f ? gp[2] / lwv : 0.f; }
#pragma unroll
        for (int db = 0; db < 4; ++db) {
            f32x4 v;
            const int col = 64 * hl + 16 * db + 4 * fq;
            if (MODE == 3) {
                const u32x2 c2_ = *(const u32x2*)(a.ocmp + tok * 512 + col);
                v[0] = g0 * bf2f(c2_.x & 0xffffu) + g1 * o[i][db][0] + g2 * ow[i][db][0];
                v[1] = g0 * bf2f(c2_.x >> 16) + g1 * o[i][db][1] + g2 * ow[i][db][1];
                v[2] = g0 * bf2f(c2_.y & 0xffffu) + g1 * o[i][db][2] + g2 * ow[i][db][2];
                v[3] = g0 * bf2f(c2_.y >> 16) + g1 * o[i][db][3] + g2 * ow[i][db][3];
            } else v = o[i][db] * inv;
            u32x2 wv; wv.x = cvtpk(v[0], v[1]); wv.y = cvtpk(v[2], v[3]);
            *(u32x2*)(a.O + tok * ldo_loc + col0_loc + col) = wv;
        }
    }
}

__device__ __forceinline__ void attn_cmp(LAS unsigned char* lds, const bf16_t* QC, const bf16_t* KCMP, const bf16_t* VCMP, bf16_t* OCMP, unsigned long long* SEL, float shiftC, int b, int hkv, int qt) {
    constexpr int NC = 2;
    int tid_ = threadIdx.x; asm volatile("" : "+v"(tid_));
    const int tid = tid_, w = __builtin_amdgcn_readfirstlane(tid >> 6), lane = tid & 63, fr = lane & 15, fq = lane >> 4;
    const int q0 = qt * 64, qw0 = q0 + 16 * (w >> 1), qpos = qw0 + fr, hbase = hkv * 4 + 2 * (w & 1);
    const float sh = uniform_f(shiftC);
    bf16x8 qf[2][NC];
#pragma unroll
    for (int i = 0; i < 2; ++i) { const bf16_t* qp = QC + ((size_t)(b * 8 + hbase + i) * SEQ + qpos) * 64 + 8 * fq;
#pragma unroll
        for (int c = 0; c < NC; ++c) qf[i][c] = *(const bf16x8*)(qp + 32 * c); }
    const bf16_t* Kb = KCMP + (size_t)(b * 2 + hkv) * 256 * 64; const bf16_t* Vb = VCMP + (size_t)(b * 2 + hkv) * 256 * 64;
    const int jb = q0 + 63 - 31;
    const int nt = ((jb >> 4) >> 6) + 1;
    const int jw = qw0 + 15 - 31;
    const int ntw = jw < 0 ? 0 : ((jw >> 4) >> 6) + 1;
    u32x4 kr[4], vr[4], dummy = (u32x4){0u, 0u, 0u, 0u};
#pragma unroll
    for (int kt = 0; kt < 4; ++kt) { const int tl = kt < nt ? kt : 0; tile_load<NC>(Kb, Vb, tl, kr[kt], dummy, vr[kt], tid, true); }
    __syncthreads();
#pragma unroll
    for (int kt = 0; kt < 4; ++kt) tile_store<NC>(lds + kt * AL_BUF, kr[kt], dummy, vr[kt], tid, true);
    LAS float* imp = (LAS float*)(lds + AL_IMP) + w * (16 * 65);
    for (int i = lane; i < 16 * 65; i += 64) imp[i] = 0.f;
    __syncthreads();
    f32x4 o[2][4], lacc[2];
#pragma unroll
    for (int i = 0; i < 2; ++i) { lacc[i] = (f32x4){0.f, 0.f, 0.f, 0.f};
#pragma unroll
        for (int d = 0; d < 4; ++d) o[i][d] = (f32x4){0.f, 0.f, 0.f, 0.f}; }
    float va[2][4][4], vb[2][4][4];
#pragma unroll
    for (int g = 0; g < 2; ++g)
#pragma unroll
        for (int kt = 0; kt < 4; ++kt)
#pragma unroll
            for (int kb = 0; kb < 4; ++kb) { va[g][kt][kb] = 0.f; vb[g][kt][kb] = 0.f; }
    const u32x4 onesw = {0x3f803f80u, 0x3f803f80u, 0x3f803f80u, 0x3f803f80u}; const bf16x8 ones = __builtin_bit_cast(bf16x8, onesw);
#pragma unroll
    for (int kt = 0; kt < 4; ++kt) {
        if (kt < ntw) {
            f32x4 s[2][4];
            attn_s_pair<NC>(lds + kt * AL_BUF + AL_K, qf[0], qf[1], s, fr, fq, -sh, -sh);
            bf16x8 pf[2][2];
#pragma unroll
            for (int g = 0; g < 2; ++g) {
#pragma unroll
                for (int kb = 0; kb < 4; ++kb) {
#pragma unroll
                    for (int e = 0; e < 4; ++e) { const int j = 64 * kt + 16 * kb + 4 * fq + e; const bool valid = (16 * j + 31 <= qpos) && (j < 255);
                        s[g][kb][e] = fast_exp2(valid ? s[g][kb][e] : -INFINITY); }
                    va[g][kt][kb] = (s[g][kb][0] + s[g][kb][1]) + (s[g][kb][2] + s[g][kb][3]); vb[g][kt][kb] = s[g][kb][3]; }
                pf[g][0] = pack_p(s[g][0], s[g][1]); pf[g][1] = pack_p(s[g][2], s[g][3]);
                lacc[g] = MFMA16(ones, pf[g][0], lacc[g]); lacc[g] = MFMA16(ones, pf[g][1], lacc[g]); }
            attn_pv_pair(lds + kt * AL_BUF + AL_V, pf, o[0], o[1], fr, fq);
        }
    }
    float invl[2];
#pragma unroll
    for (int i = 0; i < 2; ++i) { const float lt = lacc[i][0]; invl[i] = lt > 0.f ? 1.0f / lt : 0.f; }
#pragma unroll
    for (int i = 0; i < 2; ++i) { const size_t tok = (size_t)b * SEQ + qpos;
#pragma unroll
        for (int db = 0; db < 4; ++db) { const f32x4 v = o[i][db] * invl[i]; u32x2 wv; wv.x = cvtpk(v[0], v[1]); wv.y = cvtpk(v[2], v[3]);
            *(u32x2*)(OCMP + tok * 512 + 64 * (hbase + i) + 16 * db + 4 * fq) = wv; } }
    LDS_WAIT();
#pragma unroll
    for (int kt = 0; kt < 4; ++kt)
#pragma unroll
        for (int kb = 0; kb < 4; ++kb) imp[fr * 65 + 16 * kt + 4 * kb + fq] = va[0][kt][kb] * invl[0] + va[1][kt][kb] * invl[1];
    LDS_WAIT();
#pragma unroll
    for (int kt = 0; kt < 4; ++kt)
#pragma unroll
        for (int kb = 0; kb < 4; ++kb) { imp[fr * 65 + 16 * kt + 4 * kb + fq + 1] += vb[0][kt][kb] * invl[0] + vb[1][kt][kb] * invl[1]; LDS_WAIT(); }
    __syncthreads();
    const LAS float* impo = (const LAS float*)(lds + AL_IMP) + (w ^ 1) * (16 * 65);
#pragma unroll 1
    for (int r8 = 0; r8 < 8; ++r8) {
        const int r = 8 * (w & 1) + r8, q = qw0 + r, cur = q >> 6, sblk = lane;
        const float v = imp[r * 65 + lane] + impo[r * 65 + lane];
        const bool future = sblk > cur, forced = (sblk == 0) || (sblk == cur) || (sblk == cur - 1);
        unsigned key = forced ? 0x461C4000u : (__builtin_bit_cast(unsigned, v) & ~63u);
        key = future ? 0u : ((key | (unsigned)(63 - sblk)) + 64u);
        unsigned thr = 0u;
#pragma unroll
        for (int bit = 31; bit >= 0; --bit) { const unsigned cand = thr | (1u << bit); if (__popcll(__ballot(key >= cand)) >= 8) thr = cand; }
        const bool selb = (key >= thr) && (key != 0u);
        const unsigned long long mask = __ballot(selb);
        if (lane == 0) SEL[(size_t)(b * 2 + hkv) * SEQ + q] = mask;
    }
}

__device__ __forceinline__ void attn_phase_main(const Params& p, LAS unsigned char* lds, int l, int G) {
    unsigned char* ws = p.ws; unsigned char* r1 = ws + WS_R1; unsigned char* r2 = ws + WS_R2;
    bf16_t* O = (bf16_t*)(ws + WS_U);
    int tl_ = threadIdx.x; asm volatile("" : "+v"(tl_)); const int lane_ = tl_ & 63;
    const float gAq = wave_max(fabsf(p.a_qk_g[(l * 2 + 0) * 64 + lane_])), gAk = wave_max(fabsf(p.a_qk_g[(l * 2 + 1) * 64 + lane_]));
    const float gCq = wave_max(fabsf(p.c_qk_g[(l * 4 + 0) * 64 + lane_])), gCw = wave_max(fabsf(p.c_qk_g[(l * 4 + 3) * 64 + lane_]));
    const float gBqn = wave_max(fabsf(p.b_qk_nope_g[(l * 2 + 0) * 64 + lane_])), gBkn = wave_max(fabsf(p.b_qk_nope_g[(l * 2 + 1) * 64 + lane_]));
    const float gBqr = wave_max(fabsf(p.b_qk_rope_g[(l * 2 + 0) * 32 + (lane_ & 31)])), gBkr = wave_max(fabsf(p.b_qk_rope_g[(l * 2 + 1) * 32 + (lane_ & 31)]));
    const float gCk = wave_max(fabsf(p.c_qk_g[(l * 4 + 1) * 64 + lane_])); const float shC = uniform_f(1.02f * 8.0f * gCq * gCk * LOG2E);
    const float gCs = wave_max(fabsf(p.c_qk_g[(l * 4 + 2) * 64 + lane_])); const float shS = uniform_f(1.02f * 8.0f * gCq * gCs * LOG2E);
    const float shA = uniform_f(1.02f * 8.0f * gAq * gAk * LOG2E), shW = uniform_f(1.02f * 8.0f * gCq * gCw * LOG2E);
    const float shB = uniform_f(1.02f * sqrtf((64.f * gBqn * gBqn + 32.f * gBqr * gBqr) * (64.f * gBkn * gBkn + 32.f * gBkr * gBkr)) * 0.10206207261596575f * LOG2E);
    volatile LAS float* shl = (volatile LAS float*)(lds + 131072 + 64);
    __syncthreads();
    if (tl_ == 0) { shl[0] = shA; shl[1] = shB; shl[2] = shC; shl[3] = shS; shl[4] = shW; }
    __syncthreads();
    constexpr int NU = 512 + 512 + 1024;
    for (int ui = blockIdx.x; ui < NU; ui += G) {
        if (ui < 512) {
            int qt, bh;
            if (G == 256) { const int xcd = blockIdx.x & 7, loc = blockIdx.x >> 3, hs = loc >> 4, q = loc & 15; if (ui < 256) { bh = xcd + 8 * hs; qt = 15 - q; } else { bh = xcd + 8 * (2 + hs); qt = q; } }
            else { const int j = ui < 256 ? ui : 767 - ui; qt = 15 - (j >> 5); bh = j & 31; }
            AttnPtrs a{(const bf16_t*)(r1 + R1_QB), (const bf16_t*)(r1 + R1_KB), (const bf16_t*)(r1 + R1_VB), O, DM, 256, 0.10206207261596575f * LOG2E, shl[1], nullptr, nullptr, nullptr, nullptr, nullptr, nullptr, 0.f};
            for (int rep = 0; rep < UREP(0); ++rep) attn_flash<1>(lds, a, bh >> 2, bh & 3, qt);
        } else if (ui < 1024) {
            int u = ui - 512;
            if (G == 256) { const int xcd = blockIdx.x & 7, loc = blockIdx.x >> 3, r = u >> 8; u = (xcd + 8 * r) * 32 + loc; }
            AttnPtrs a{(const bf16_t*)(r2 + R2_QA), (const bf16_t*)(r2 + R2_KA), (const bf16_t*)(r2 + R2_VA), O, DM, 0, 0.125f * LOG2E, shl[0], p.a_sinks + l * 4, nullptr, nullptr, nullptr, nullptr, nullptr, 0.f};
            for (int rep = 0; rep < UREP(1); ++rep) attn_flash<0>(lds, a, u >> 6, (u >> 5) & 1, u & 31);
        } else {
            int u = ui - 1024;
            if (G == 256) { const int xcd = blockIdx.x & 7, loc = blockIdx.x >> 3, r = u >> 8;
                u = (xcd + 8 * (r >> 1)) * 64 + ((r & 1) ? loc : 63 - loc); }
            for (int rep = 0; rep < UREP(3); ++rep) {
                attn_cmp(lds, (const bf16_t*)(r2 + R2_QC), (const bf16_t*)(r2 + R2_KCMP), (const bf16_t*)(r2 + R2_VCMP), (bf16_t*)(r1 + R1_OCMP), (unsigned long long*)(r2 + R2_SEL), shl[2], u >> 7, (u >> 6) & 1, u & 63);
                asm volatile("s_waitcnt vmcnt(0)" ::: "memory");
                __syncthreads();
                AttnPtrs a{(const bf16_t*)(r2 + R2_QCR), (const bf16_t*)(r2 + R2_KS), (const bf16_t*)(r2 + R2_VS), O, DM, 512, 0.125f * LOG2E, shl[3], nullptr,
                           (const unsigned long long*)(r2 + R2_SEL), (const float*)(r2 + R2_GATES), (const bf16_t*)(r1 + R1_OCMP), (const bf16_t*)(r2 + R2_KW), (const bf16_t*)(r2 + R2_VW), shl[4]};
                attn_flash<3>(lds, a, u >> 7, (u >> 6) & 1, u & 63);
            }
        }
    }
    __syncthreads();
}
__device__ __forceinline__ void attn_phase_slc(const Params& p, LAS unsigned char* lds, int l, int G) {
    unsigned char* ws = p.ws; unsigned char* r1 = ws + WS_R1; unsigned char* r2 = ws + WS_R2;
    int tl_ = threadIdx.x; asm volatile("" : "+v"(tl_)); const int lane_ = tl_ & 63;
    const float gCq = wave_max(fabsf(p.c_qk_g[(l * 4 + 0) * 64 + lane_])), gCs = wave_max(fabsf(p.c_qk_g[(l * 4 + 2) * 64 + lane_]));
    const float shS = uniform_f(1.02f * 8.0f * gCq * gCs * LOG2E);
    const float gCw2 = wave_max(fabsf(p.c_qk_g[(l * 4 + 3) * 64 + lane_])); const float shW2 = uniform_f(1.02f * 8.0f * gCq * gCw2 * LOG2E);
    for (int u0 = blockIdx.x; u0 < 1024; u0 += G) {
        int u = u0;
        if (G == 256) { const int xcd = blockIdx.x & 7, loc = blockIdx.x >> 3, r = u0 >> 8;
            u = (xcd + 8 * (r >> 1)) * 64 + ((r & 1) ? loc : 63 - loc); }
        AttnPtrs a{(const bf16_t*)(r2 + R2_QCR), (const bf16_t*)(r2 + R2_KS), (const bf16_t*)(r2 + R2_VS), (bf16_t*)(ws + WS_U), DM, 512, 0.125f * LOG2E, shS, nullptr,
                   (const unsigned long long*)(r2 + R2_SEL), (const float*)(r2 + R2_GATES), (const bf16_t*)(r1 + R1_OCMP), (const bf16_t*)(r2 + R2_KW), (const bf16_t*)(r2 + R2_VW), shW2};
        attn_flash<3>(lds, a, u >> 7, (u >> 6) & 1, u & 63);
    }
    __syncthreads();
}

__global__ void __launch_bounds__(NTHREADS, 2) fwd_megakernel(Params p) {
    extern __shared__ __attribute__((aligned(16))) unsigned char smem[];
    LAS unsigned char* lds = (LAS unsigned char*)smem;
    cg::grid_group grid = cg::this_grid();
    const int G = gridDim.x, ngw = G * NWAVES;
    volatile LAS unsigned* bst = (volatile LAS unsigned*)(lds + 131072);
    if (threadIdx.x < 2) bst[threadIdx.x] = 0u;
    __syncthreads();
    (void)xcd_barrier_post((unsigned*)(p.ws + WS_BAR), bst);
    for (int ph = p.ph_lo; ph < p.ph_hi; ++ph) {
        bool nosync = false;
#define MKLANE int tid_ = threadIdx.x; asm volatile("" : "+v"(tid_)); const int tid = tid_, lane = tid & 63, wave = __builtin_amdgcn_readfirstlane(tid >> 6), gw = blockIdx.x * NWAVES + wave; (void)tid; (void)lane; (void)wave; (void)gw;
        unsigned char* ws = p.ws; asm volatile("" : "+s"(ws));
        if (ph == 0) { MKLANE if (PHON(0)) for (int rep = 0; rep < NREP(0); ++rep) { prologue(p, lds, tid, wave, lane, G); __syncthreads(); } }
        else {
            const int l = (ph - 1) / 16, k = (ph - 1) % 16;
            const float* modl = (const float*)(ws + WS_MOD) + (size_t)l * NBATCH * NMOD * DM;
            if (PHON(1) && (k == 0 || k == 3 || k == 13) && !(FUSE_NORM && G == 256 && !(l == 0 && k == 0))) {
                MKLANE
                const int j = k == 0 ? 0 : (k == 3 ? 1 : 2);
                const float* hin = (l == 0 && k == 0) ? p.x : p.out;
                if (l == 0 && k == 0 && blockIdx.x == 0) {
                    const float* CMPBP = (const float*)(ws + WS_CMPBP); float* CMPB = (float*)(ws + WS_CMPB);
                    for (int i = tid; i < 8 * 128; i += NTHREADS) { const int m = i >> 7, n = i & 127; float a = 0.f;
                        for (int sl = 0; sl < 32; ++sl) a += CMPBP[((size_t)m * 32 + sl) * 128 + n];
                        CMPB[i] = a; }
                }
                for (int rep = 0; rep < NREP(1); ++rep) norm_phase(hin, (bf16_t*)(ws + WS_U), p.norm_g + (size_t)(l * 3 + j) * DM, modl, 3 * j + 1, 3 * j, gw, ngw, lane);
            } else if (PHON(2) && (k == 1 || k == 14)) {
                const int f = k == 1 ? 0 : 1;
                pg8::Gemm g{(const bf16_t*)(ws + WS_U), (const bf16_t*)(ws + WS_W1T) + (size_t)(l * 2 + f) * 2 * DFF * DM, DM, DM, T, 2 * DFF, DM};
                pg8::StaticOrder S; S.init(g.M, g.N, G, blockIdx.x);
                pg8::EpiSwiglu E{(bf16_t*)(ws + WS_R1)};
                for (int rep = 0; rep < NREP(2); ++rep) pg8::gemm_phase(lds, g, S, E);
            } else if (PHON(3) && (k == 2 || k == 12 || k == 15)) {
                pg8::Gemm g;
                if (k == 12) g = pg8::Gemm{(const bf16_t*)(ws + WS_U), (const bf16_t*)(ws + WS_WOUTT) + (size_t)l * DM * DM, DM, DM, T, DM, DM};
                else g = pg8::Gemm{(const bf16_t*)(ws + WS_R1), (const bf16_t*)(ws + WS_W2T) + (size_t)(l * 2 + (k == 2 ? 0 : 1)) * DM * DFF, DFF, DFF, T, DM, DFF};
                pg8::StaticOrder S; S.init(g.M, g.N, G, blockIdx.x);
                const int gi = k == 2 ? 2 : (k == 12 ? 5 : 8);
                for (int rep = 0; rep < NREP(3); ++rep) {
                    const bool fuse = FUSE_NORM && G == 256 && !(k == 15 && l == DEPTH - 1) && (rep + 1 == NREP(3));
                    const int ln = k == 15 ? l + 1 : l, jn = k == 2 ? 1 : (k == 12 ? 2 : 0), call = l * 3 + (k == 2 ? 0 : (k == 12 ? 1 : 2));
                    const float* modn = (const float*)(ws + WS_MOD) + (size_t)ln * NBATCH * NMOD * DM;
                    pg8::EpiResid E{(l == 0 && k == 2) ? p.x : p.out, p.out, modl + gi * DM, (rep + 1 < NREP(3)) ? 0.0f : (k == 12 ? 1.0f : 0.5f),
                                    fuse ? p.norm_g + (size_t)(ln * 3 + jn) * DM : nullptr, modn + (3 * jn + 1) * DM, modn + (3 * jn) * DM, (bf16_t*)(ws + WS_U), (float*)(ws + WS_XBUF),
                                    (unsigned*)(ws + WS_BAR + 16384) + call * 128, lds + 131072 + 256};
                    pg8::gemm_phase(lds, g, S, E);
                }
            } else if (PHON(4) && k == 4) {
                pg8::Gemm g{(const bf16_t*)(ws + WS_U), (const bf16_t*)(ws + WS_WINT) + (size_t)l * DINP * DM, DM, DM, T, DINP, DM};
                unsigned char* r2 = ws + WS_R2;
                pg8::EpiMixIn E{(bf16_t*)(r2 + R2_QA), (bf16_t*)(r2 + R2_KA), (bf16_t*)(r2 + R2_VA), (bf16_t*)(r2 + R2_QC), (bf16_t*)(r2 + R2_QCR), (bf16_t*)(r2 + R2_ZK), (bf16_t*)(r2 + R2_ZV),
                                (bf16_t*)(r2 + R2_KS), (bf16_t*)(r2 + R2_VS), (bf16_t*)(r2 + R2_KW), (bf16_t*)(r2 + R2_VW), (bf16_t*)(ws + WS_R1),
                                p.a_qk_g + (l * 2 + 0) * 64, p.a_qk_g + (l * 2 + 1) * 64, p.c_qk_g + (l * 4 + 0) * 64, p.c_qk_g + (l * 4 + 2) * 64, p.c_qk_g + (l * 4 + 3) * 64,
                                (const float*)(ws + WS_COS64), (const float*)(ws + WS_SIN64)};
                pg8::StaticOrder S; S.init(g.M, g.N, G, blockIdx.x);
                for (int rep = 0; rep < NREP(4); ++rep) pg8::gemm_phase(lds, g, S, E);
            } else if (PHON(4) && (k == 6 || k == 7)) {
                pg8::Gemm g;
                if (k == 6) g = pg8::Gemm{(const bf16_t*)(ws + WS_R2 + R2_CQN), (const bf16_t*)(ws + WS_WUQT) + (size_t)l * 512 * 256, 256, 256, T, 512, 256};
                else g = pg8::Gemm{(const bf16_t*)(ws + WS_R2 + R2_CKVN), (const bf16_t*)(ws + WS_WUKVT) + (size_t)l * 512 * 128, 128, 128, T, 512, 128};
                pg8::EpiMixB E{k == 6, (bf16_t*)(ws + WS_R1 + R1_QB), (bf16_t*)(ws + WS_R1 + R1_KB), (bf16_t*)(ws + WS_R1 + R1_VB), (const bf16_t*)(ws + WS_R2 + R2_KPE),
                               p.b_qk_nope_g + (l * 2 + 0) * 64, p.b_qk_rope_g + (l * 2 + 0) * 32, p.b_qk_nope_g + (l * 2 + 1) * 64, (const float*)(ws + WS_COS32), (const float*)(ws + WS_SIN32)};
                pg8::StaticOrder S; S.init(g.M, g.N, G, blockIdx.x);
                for (int rep = 0; rep < NREP(4); ++rep) pg8::gemm_phase(lds, g, S, E);
                if (k == 7 && PHON(6)) { MKLANE for (int rep = 0; rep < NREP(6); ++rep) postproc_b(p, lds, l, gw, ngw, lane); }
            } else if (PHON(5) && k == 5) {
                { MKLANE
                  for (int rep = 0; rep < NREP(5); ++rep) postproc_a2(p, lds, l, gw, ngw, lane); }
                __syncthreads();
                pg8::Gemm g{(const bf16_t*)(ws + WS_R2 + R2_ZK), (const bf16_t*)(ws + WS_WC1T) + (size_t)l * 256 * 2048, 1024, 2048, 8192, 256, 512, 1024};
                pg8::StaticOrder S; S.init(g.M, 4 * 256, G, blockIdx.x);
                pg8::EpiCmp E{(float*)(ws + WS_R1 + R1_HIDP)};
                for (int rep = 0; rep < NREP(9); ++rep) pg8::gemm_phase(lds, g, S, E);
            } else if (PHON(7) && k == 10) {
                for (int rep = 0; rep < NREP(7); ++rep) attn_phase_main(p, lds, l, G);
            }
            nosync = (k == 6 || k == 8 || k == 9 || k == 11) || (FUSE_NORM && G == 256 && (k == 0 || k == 3 || k == 13) && !(l == 0 && k == 0));
        }
        if (ph + 1 < p.ph_hi && !nosync) for (int rep = 0; rep < NREP(10); ++rep) {
            if (ph == 0) grid.sync();
            else { XcdBarrier xb_; xb_.bar = (unsigned*)(p.ws + WS_BAR); xb_.x = xb_xcc_id(); xb_.st = (volatile LAS unsigned*)(lds + 131072); xcd_barrier(xb_); }
        }
    }
}

constexpr int LDS_BYTES = 144 * 1024;
constexpr int NPHASES = 1 + 16 * DEPTH;
extern "C" void kernel_launch(void* const* d_in, const int* in_sizes, int n_in, void* d_out, int out_size, void* d_ws, size_t ws_size, hipStream_t stream) {
    static int grid = 0;
    if (grid == 0) {
        if (n_in != 24 || out_size != T * DM || ws_size < WS_END) { fprintf(stderr, "kernel_launch: unexpected problem (n_in %d, out %d, ws %zu; need ws >= %zu)\n", n_in, out_size, ws_size, (size_t)WS_END); grid = -1; return; }
        int dev = 0, cus = 0, per_cu = 0;
        hipGetDevice(&dev);
        hipDeviceGetAttribute(&cus, hipDeviceAttributeMultiprocessorCount, dev);
        if (hipFuncSetAttribute((const void*)fwd_megakernel, hipFuncAttributeMaxDynamicSharedMemorySize, LDS_BYTES) != hipSuccess) { fprintf(stderr, "kernel_launch: hipFuncSetAttribute failed\n"); grid = -1; return; }
        if (hipOccupancyMaxActiveBlocksPerMultiprocessor(&per_cu, (const void*)fwd_megakernel, NTHREADS, LDS_BYTES) != hipSuccess || per_cu < 1) { fprintf(stderr, "kernel_launch: occupancy query says %d\n", per_cu); per_cu = 1; }
        (void)hipGetLastError();
        grid = cus * 1;
        fprintf(stderr, "kernel_launch: grid %d (occupancy %d/CU)\n", grid, per_cu);
    }
    if (grid < 0) return;
    Params p{};
    const float** fp = (const float**)&p;
    for (int i = 0; i < 24; ++i) fp[i] = (const float*)d_in[i];
    p.out = (float*)d_out; p.ws = (unsigned char*)d_ws;
#if MK_ONE_LAUNCH
    if (hipMemsetAsync((unsigned char*)d_ws + WS_BAR, 0, BAR_BYTES, stream) != hipSuccess) { fprintf(stderr, "kernel_launch: memset failed\n"); return; }
    p.ph_lo = 0; p.ph_hi = NPHASES;
    void* args[] = {&p};
    hipError_t e = hipLaunchCooperativeKernel((const void*)fwd_megakernel, dim3(grid), dim3(NTHREADS), args, LDS_BYTES, stream);
    if (e != hipSuccess) fprintf(stderr, "kernel_launch: cooperative launch failed: %s (grid %d)\n", hipGetErrorString(e), grid);
#else
    for (int ph = 0; ph < NPHASES; ++ph) { p.ph_lo = ph; p.ph_hi = ph + 1; hipLaunchKernelGGL(fwd_megakernel, dim3(grid), dim3(NTHREADS), LDS_BYTES, stream, p); }
#endif
}
```

```cpp
#include <hip/hip_runtime.h>
#include <hip/hip_cooperative_groups.h>
#include <cstdio>
#include <cstdint>
namespace cg = cooperative_groups;

#define LAS __attribute__((address_space(3)))
typedef unsigned short bf16_t;
typedef short bf16x8 __attribute__((ext_vector_type(8)));
typedef short bf16x4 __attribute__((ext_vector_type(4)));
typedef float f32x4 __attribute__((ext_vector_type(4)));
typedef float f32x2 __attribute__((ext_vector_type(2)));
typedef unsigned u32x4 __attribute__((ext_vector_type(4)));
typedef unsigned u32x2 __attribute__((ext_vector_type(2)));
typedef __bf16 bf16x2_t __attribute__((ext_vector_type(2)));

#ifndef PHM
#define PHM 0xffff
#endif
#define PHON(n) (((PHM) >> (n)) & 1)
#ifndef DUPM
#define DUPM 0
#endif
#define NREP(n) (1 + (((DUPM) >> (n)) & 1))
#ifndef DUPU
#define DUPU 0
#endif
#define UREP(n) (1 + (((DUPU) >> (n)) & 1))
#ifndef FUSE_NORM
#define FUSE_NORM 1
#endif
#ifndef MK_ONE_LAUNCH
#define MK_ONE_LAUNCH 1
#endif

constexpr int DM = 1024, NBATCH = 8, SEQ = 4096, T = NBATCH * SEQ, DEPTH = 4, DFF = 2816, NMOD = 9;
constexpr int DIN = 2272, DINP = 2304;
constexpr float EPS = 1e-6f, LOG2E = 1.4426950408889634f;
constexpr int NTHREADS = 512, NWAVES = 8;

constexpr size_t MiB = 1u << 20;
constexpr size_t WS_MOD = 0;
constexpr size_t WS_CMPB = 2 * MiB;
constexpr size_t WS_CMPBP = 2 * MiB + 65536;
constexpr size_t WS_BAR = 2 * MiB + 524288, BAR_BYTES = 16384 + 8192;
constexpr size_t WS_XBUF = 15 * MiB;
constexpr size_t WS_COS64 = 3 * MiB, WS_SIN64 = 7 * MiB, WS_COS32 = 11 * MiB, WS_SIN32 = 13 * MiB;
constexpr size_t WS_W1T = 16 * MiB;
constexpr size_t WS_W2T = 104 * MiB;
constexpr size_t WS_WINT = 148 * MiB;
constexpr size_t WS_WOUTT = 166 * MiB;
constexpr size_t WS_WUQT = 174 * MiB;
constexpr size_t WS_WUKVT = 175 * MiB;
constexpr size_t WS_WC1T = 176 * MiB;
constexpr size_t WS_U = 180 * MiB;
constexpr size_t WS_R1 = 244 * MiB;
constexpr size_t WS_R2 = 420 * MiB;
constexpr size_t WS_END = 596 * MiB;
constexpr size_t R1_HIDP = 130 * MiB;
constexpr size_t R1_QBR = 0, R1_KVBR = 32 * MiB, R1_HID = 64 * MiB, R1_QB = 66 * MiB, R1_KB = 90 * MiB, R1_VB = 114 * MiB, R1_OWIN = 0, R1_OCMP = 32 * MiB;
constexpr size_t R2_QA = 0, R2_KA = 16 * MiB, R2_VA = 24 * MiB, R2_CQN = 32 * MiB, R2_CKVN = 48 * MiB, R2_KPE = 56 * MiB, R2_QC = 58 * MiB, R2_QCR = 90 * MiB,
                 R2_ZK = 122 * MiB, R2_ZV = 130 * MiB, R2_KS = 139 * MiB, R2_VS = 147 * MiB, R2_KW = 155 * MiB, R2_VW = 163 * MiB, R2_GATES = 171 * MiB,
                 R2_KCMP = 174 * MiB, R2_VCMP = 174 * MiB + 512 * 1024, R2_SEL = 175 * MiB;

__device__ __forceinline__ unsigned cvtpk(float lo, float hi) { f32x2 v = {lo, hi}; bf16x2_t b = __builtin_convertvector(v, bf16x2_t); return __builtin_bit_cast(unsigned, b); }
__device__ __forceinline__ unsigned f2bf(float f) { unsigned u = __builtin_bit_cast(unsigned, f); return (u + 0x7fffu + ((u >> 16) & 1u)) >> 16; }
__device__ __forceinline__ unsigned pk2(float lo, float hi) { return f2bf(lo) | (f2bf(hi) << 16); }
__device__ __forceinline__ float bf2f(unsigned h) { return __builtin_bit_cast(float, h << 16); }
__device__ __forceinline__ float wave_sum(float v) {
#pragma unroll
    for (int o = 1; o < 64; o <<= 1) v += __shfl_xor(v, o);
    return v;
}
__device__ __forceinline__ float wave_max(float v) {
#pragma unroll
    for (int o = 1; o < 64; o <<= 1) v = fmaxf(v, __shfl_xor(v, o));
    return v;
}
__device__ __forceinline__ float uniform_f(float v) { return __builtin_bit_cast(float, __builtin_amdgcn_readfirstlane(__builtin_bit_cast(int, v))); }
__device__ __forceinline__ float fast_exp2(float x) { return __builtin_amdgcn_exp2f(x); }
__device__ __forceinline__ float silu_f(float g) { return g * __builtin_amdgcn_rcpf(1.0f + fast_exp2(-g * LOG2E)); }
#define LDS_WAIT() asm volatile("s_waitcnt lgkmcnt(0)" ::: "memory")

namespace pg8 {
constexpr int BM = 256, BK = 64, HALF = 128, HTB = HALF * BK * 2, STAGE_BYTES = 8 * HTB, NXCD = 8, WGM = 8;
__host__ __device__ __forceinline__ int lds_byte(int r, int c) { const int st = (r >> 4) * 2 + (c >> 5), rr = r & 15, cc = c & 31, ob = rr * 64 + cc * 2; return st * 1024 + (ob ^ (((ob >> 9) & 1) << 5)); }
__host__ __device__ __forceinline__ void stage_rc(int b, int& R, int& C) { const int st = b / 1024, sb = b % 1024, swz = sb ^ (((sb >> 9) & 1) << 5); R = (st >> 1) * 16 + swz / 64; C = (st & 1) * 32 + (swz % 64) / 2; }
__host__ __device__ __forceinline__ int perm32(int rho) { const int n = rho >> 4, i = rho & 15; return 8 * (i >> 2) + 4 * n + (i & 3); }

struct Unit { int pm, pn; };
struct Gemm { const bf16_t* A; const bf16_t* Bt; int lda, ldb, M, N, K; int ksb = 0; };

struct StaticOrder {
    int nM, nN, nwg, G, c;
    __device__ void init(int M, int N, int G_, int c_) { nM = M / BM; nN = N / BM; nwg = nM * nN; G = G_; c = c_; }
    __device__ bool next(int i, Unit& u) const {
        const long L = (long)i * G + c; if (L >= nwg) return false;
        int wgid = (int)L; { const int q = nwg / NXCD, r = nwg % NXCD, xcd = wgid % NXCD, off = wgid / NXCD; wgid = (xcd < r ? xcd * (q + 1) : r * (q + 1) + (xcd - r) * q) + off; }
        const int nig = WGM * nN, gid = wgid / nig, fm = gid * WGM, gsz = (nM - fm) < WGM ? (nM - fm) : WGM;
        u.pm = fm + ((wgid % nig) % gsz); u.pn = (wgid % nig) / gsz; return true;
    }
};

struct EpiMixIn {
    static constexpr bool A_NT = false; static constexpr bool PERM = true;
    bf16_t *QA, *KA, *VA, *QC, *QCR, *ZK, *ZV, *KS, *VS, *KW, *VW, *P2;
    const float *gaq, *gak, *gcq, *gcs, *gcw, *C64, *S64;
    __device__ __forceinline__ void operator()(const f32x4 (&acc)[2][2][4][2], const Unit& u, int wr, int wc, int fr, int fq) const {
        const int pn = u.pn, row0 = u.pm * BM + wr * 64 + fr;
        if (pn >= 7) {
            const int col0 = (pn - 7) * BM + wc * 32 + 8 * fq;
#pragma unroll
            for (int ai = 0; ai < 2; ++ai)
#pragma unroll
                for (int m = 0; m < 4; ++m) { bf16_t* rowp = P2 + (size_t)(row0 + ai * HALF + m * 16) * 512 + col0;
#pragma unroll
                    for (int bj = 0; bj < 2; ++bj) { const f32x4 v0 = acc[ai][bj][m][0], v1 = acc[ai][bj][m][1];
                        u32x4 w; w.x = cvtpk(v0[0], v0[1]); w.y = cvtpk(v0[2], v0[3]); w.z = cvtpk(v1[0], v1[1]); w.w = cvtpk(v1[2], v1[3]);
                        *(u32x4*)(rowp + bj * HALF) = w; } }
            return;
        }
        bf16_t* dst; const float* gp = nullptr; int Hn, h; bool rope = false; float scale = 1.0f; bool two = false;
        const bool lo = wc < 2; const int h2 = wc & 1;
        if (pn == 0) { dst = QA; Hn = 4; h = wc; gp = gaq; rope = true; scale = 0.125f * LOG2E; }
        else if (pn == 1) { Hn = 2; h = h2; if (lo) { dst = KA; gp = gak; rope = true; } else dst = VA; }
        else if (pn <= 3) { dst = QCR; Hn = 8; h = 4 * (pn - 2) + wc; gp = gcq; rope = true; scale = 0.125f * LOG2E; two = true; }
        else if (pn == 4) { Hn = 2; h = h2; dst = lo ? ZK : ZV; }
        else if (pn == 5) { Hn = 2; h = h2; if (lo) { dst = KS; gp = gcs; rope = true; } else dst = VS; }
        else { Hn = 2; h = h2; if (lo) { dst = KW; gp = gcw; rope = true; } else dst = VW; }
        f32x4 ga[2], gb[2];
#pragma unroll
        for (int n = 0; n < 2; ++n) { ga[n] = gp ? *(const f32x4*)(gp + 8 * fq + 4 * n) : (f32x4){1.f, 1.f, 1.f, 1.f}; gb[n] = gp ? *(const f32x4*)(gp + 32 + 8 * fq + 4 * n) : (f32x4){1.f, 1.f, 1.f, 1.f}; }
        const int b = u.pm >> 4;
#pragma unroll
        for (int ai = 0; ai < 2; ++ai)
#pragma unroll
            for (int m = 0; m < 4; ++m) {
                const int row = row0 + ai * HALF + m * 16, s_ = row & 4095;
                f32x4 a[2], bb[2];
#pragma unroll
                for (int n = 0; n < 2; ++n) { a[n] = acc[ai][0][m][n]; bb[n] = acc[ai][1][m][n]; }
                float r = scale;
                if (gp) { float ss = 0.f;
#pragma unroll
                    for (int n = 0; n < 2; ++n)
#pragma unroll
                        for (int e = 0; e < 4; ++e) ss += a[n][e] * a[n][e] + bb[n][e] * bb[n][e];
                    ss += __shfl_xor(ss, 16); ss += __shfl_xor(ss, 32);
                    r = rsqrtf(ss * (1.0f / 64) + EPS) * scale; }
#pragma unroll
                for (int n = 0; n < 2; ++n) { a[n] = a[n] * r * ga[n]; bb[n] = bb[n] * r * gb[n]; }
                const size_t o = ((size_t)(b * Hn + h) * SEQ + s_) * 64 + 8 * fq;
                if (two) { u32x4 w; w.x = cvtpk(a[0][0], a[0][1]); w.y = cvtpk(a[0][2], a[0][3]); w.z = cvtpk(a[1][0], a[1][1]); w.w = cvtpk(a[1][2], a[1][3]); *(u32x4*)(QC + o) = w;
                    w.x = cvtpk(bb[0][0], bb[0][1]); w.y = cvtpk(bb[0][2], bb[0][3]); w.z = cvtpk(bb[1][0], bb[1][1]); w.w = cvtpk(bb[1][2], bb[1][3]); *(u32x4*)(QC + o + 32) = w; }
                if (rope) {
#pragma unroll
                    for (int n = 0; n < 2; ++n) { const f32x4 cs = *(const f32x4*)(C64 + (size_t)row * 32 + 8 * fq + 4 * n), sn = *(const f32x4*)(S64 + (size_t)row * 32 + 8 * fq + 4 * n);
                        const f32x4 ya = a[n], yb = bb[n]; a[n] = ya * cs - yb * sn; bb[n] = yb * cs + ya * sn; } }
                u32x4 w; w.x = cvtpk(a[0][0], a[0][1]); w.y = cvtpk(a[0][2], a[0][3]); w.z = cvtpk(a[1][0], a[1][1]); w.w = cvtpk(a[1][2], a[1][3]); *(u32x4*)(dst + o) = w;
                w.x = cvtpk(bb[0][0], bb[0][1]); w.y = cvtpk(bb[0][2], bb[0][3]); w.z = cvtpk(bb[1][0], bb[1][1]); w.w = cvtpk(bb[1][2], bb[1][3]); *(u32x4*)(dst + o + 32) = w;
            }
    }
};
struct EpiMixB {
    static constexpr bool A_NT = false; static constexpr bool PERM = true;
    bool isq; bf16_t *QB, *KB, *VB; const bf16_t* KPE; const float *gqn, *gqr, *gkn, *C32, *S32;
    __device__ __forceinline__ void operator()(const f32x4 (&acc)[2][2][4][2], const Unit& u, int wr, int wc, int fr, int fq) const {
        const int pn = u.pn, row0 = u.pm * BM + wr * 64 + fr, b = u.pm >> 4;
        const float SC = 0.10206207261596575f * LOG2E;
        const bool rope = isq && pn == 1, isv = !isq && (wc & 1);
        const int h = isq ? wc : 2 * pn + (wc >> 1);
        const float* gp = isq ? (rope ? gqr : gqn) : (isv ? nullptr : gkn);
        const int hstep = rope ? 16 : 32;
        f32x4 ga[2], gb[2];
#pragma unroll
        for (int n = 0; n < 2; ++n) { const bool ok = gp && (!rope || fq < 2);
            ga[n] = ok ? *(const f32x4*)(gp + 8 * fq + 4 * n) : (f32x4){1.f, 1.f, 1.f, 1.f}; gb[n] = ok ? *(const f32x4*)(gp + hstep + 8 * fq + 4 * n) : (f32x4){1.f, 1.f, 1.f, 1.f}; }
#pragma unroll
        for (int ai = 0; ai < 2; ++ai)
#pragma unroll
            for (int m = 0; m < 4; ++m) {
                const int row = row0 + ai * HALF + m * 16, s_ = row & 4095;
                f32x4 a[2], bb[2];
#pragma unroll
                for (int n = 0; n < 2; ++n) { a[n] = acc[ai][0][m][n]; bb[n] = acc[ai][1][m][n]; }
                float r = 1.0f;
                if (gp) { float ss = 0.f;
#pragma unroll
                    for (int n = 0; n < 2; ++n)
#pragma unroll
                        for (int e = 0; e < 4; ++e) ss += a[n][e] * a[n][e] + bb[n][e] * bb[n][e];
                    ss += __shfl_xor(ss, 16); ss += __shfl_xor(ss, 32);
                    r = rsqrtf(ss * (rope ? 1.0f / 32 : 1.0f / 64) + EPS) * (isq ? SC : 1.0f); }
#pragma unroll
                for (int n = 0; n < 2; ++n) { a[n] = a[n] * r * ga[n]; bb[n] = bb[n] * r * gb[n]; }
                if (rope && fq < 2) {
#pragma unroll
                    for (int n = 0; n < 2; ++n) { const f32x4 cs = *(const f32x4*)(C32 + (size_t)row * 16 + 8 * fq + 4 * n), sn = *(const f32x4*)(S32 + (size_t)row * 16 + 8 * fq + 4 * n);
                        const f32x4 ya = a[n], yb = bb[n]; a[n] = ya * cs - yb * sn; bb[n] = yb * cs + ya * sn; } }
                u32x4 wa, wb; wa.x = cvtpk(a[0][0], a[0][1]); wa.y = cvtpk(a[0][2], a[0][3]); wa.z = cvtpk(a[1][0], a[1][1]); wa.w = cvtpk(a[1][2], a[1][3]);
                wb.x = cvtpk(bb[0][0], bb[0][1]); wb.y = cvtpk(bb[0][2], bb[0][3]); wb.z = cvtpk(bb[1][0], bb[1][1]); wb.w = cvtpk(bb[1][2], bb[1][3]);
                const size_t hs = (size_t)(b * 4 + h) * SEQ + s_;
                if (isq) { bf16_t* d = QB + hs * 96;
                    if (!rope) { *(u32x4*)(d + 8 * fq) = wa; *(u32x4*)(d + 32 + 8 * fq) = wb; }
                    else if (fq < 2) { *(u32x4*)(d + 64 + 8 * fq) = wa; *(u32x4*)(d + 80 + 8 * fq) = wb; } }
                else if (!isv) { bf16_t* d = KB + hs * 96; *(u32x4*)(d + 8 * fq) = wa; *(u32x4*)(d + 32 + 8 * fq) = wb;
                    *(u32x4*)(d + 64 + 8 * fq) = *(const u32x4*)(KPE + (size_t)row * 32 + 8 * fq); }
                else { bf16_t* d = VB + hs * 64; *(u32x4*)(d + 8 * fq) = wa; *(u32x4*)(d + 32 + 8 * fq) = wb; }
            }
    }
};
struct EpiSwiglu {
    static constexpr bool A_NT = false; static constexpr bool PERM = true;
    bf16_t* O;
    __device__ __forceinline__ void operator()(const f32x4 (&acc)[2][2][4][2], const Unit& u, int wr, int wc, int fr, int fq) const {
        const int row0 = u.pm * BM + wr * 64 + fr, col0 = u.pn * HALF + wc * 32 + 8 * fq;
#pragma unroll
        for (int ai = 0; ai < 2; ++ai)
#pragma unroll
            for (int m = 0; m < 4; ++m) { bf16_t* rowp = O + (size_t)(row0 + ai * HALF + m * 16) * DFF + col0;
                float r[8];
#pragma unroll
                for (int n = 0; n < 2; ++n)
#pragma unroll
                    for (int e = 0; e < 4; ++e) r[n * 4 + e] = silu_f(acc[ai][0][m][n][e]) * acc[ai][1][m][n][e];
                u32x4 w; w.x = cvtpk(r[0], r[1]); w.y = cvtpk(r[2], r[3]); w.z = cvtpk(r[4], r[5]); w.w = cvtpk(r[6], r[7]);
                *(u32x4*)rowp = w; }
    }
};
struct EpiResid {
    static constexpr bool A_NT = true;     static constexpr bool PERM = true;
    const float* base; float* out; const float* gate; float coef;
    const float* nxg; const float* nxsc; const float* nxsh; bf16_t* U; float* xbuf; unsigned* cnt; LAS unsigned char* xl;
    __device__ __forceinline__ void operator()(f32x4 (&acc)[2][2][4][2], const Unit& u, int wr, int wc, int fr, int fq) const {
        const float coef_ = uniform_f(coef);
        const unsigned long long nxa = (unsigned long long)(uintptr_t)this->nxg;
        const float* nxg = (const float*)(uintptr_t)(((unsigned long long)(unsigned)__builtin_amdgcn_readfirstlane((int)(nxa >> 32)) << 32) | (unsigned)__builtin_amdgcn_readfirstlane((int)nxa));
        const int b = u.pm >> 4; const float* gv = gate + (size_t)b * (NMOD * DM);
        const int col0 = u.pn * BM + wc * 32 + 8 * fq;
        f32x4 g4[2][2];
#pragma unroll
        for (int bj = 0; bj < 2; ++bj)
#pragma unroll
            for (int n = 0; n < 2; ++n) g4[bj][n] = *(const f32x4*)(gv + col0 + bj * HALF + n * 4) * coef_;
#pragma unroll
        for (int ai = 0; ai < 2; ++ai)
#pragma unroll
            for (int m = 0; m < 4; ++m) { const size_t off = (size_t)(u.pm * BM + wr * 64 + fr + ai * HALF + m * 16) * DM + col0;
#pragma unroll
                for (int bj = 0; bj < 2; ++bj)
#pragma unroll
                    for (int n = 0; n < 2; ++n) { const f32x4 bs = *(const f32x4*)(base + off + bj * HALF + n * 4);
                        const f32x4 v = bs + g4[bj][n] * acc[ai][bj][m][n]; *(f32x4*)(out + off + bj * HALF + n * 4) = v; acc[ai][bj][m][n] = v; } }
        if (!nxg) return;
        LAS float* P = (LAS float*)xl; LAS float* S = (LAS float*)(xl + 4096); LAS unsigned* flag = (LAS unsigned*)(xl + 5120);
        const int tid = threadIdx.x, wid = tid >> 6, lane = tid & 63;
#pragma unroll
        for (int ai = 0; ai < 2; ++ai)
#pragma unroll
            for (int m = 0; m < 4; ++m) { float ss = 0.f;
#pragma unroll
                for (int bj = 0; bj < 2; ++bj)
#pragma unroll
                    for (int n = 0; n < 2; ++n) { const f32x4 v = acc[ai][bj][m][n]; ss += (v[0] * v[0] + v[1] * v[1]) + (v[2] * v[2] + v[3] * v[3]); }
                ss += __shfl_xor(ss, 16); ss += __shfl_xor(ss, 32);
                if (fq == 0) P[(ai * HALF + wr * 64 + m * 16 + fr) * 4 + wc] = ss; }
        asm volatile("s_waitcnt lgkmcnt(0)" ::: "memory"); __builtin_amdgcn_s_barrier(); asm volatile("" ::: "memory");
        if (tid < 256) { const float t = (P[tid * 4 + 0] + P[tid * 4 + 1]) + (P[tid * 4 + 2] + P[tid * 4 + 3]);
            __hip_atomic_store(xbuf + ((size_t)(u.pm * BM + tid) * 4 + u.pn), t, __ATOMIC_RELAXED, __HIP_MEMORY_SCOPE_AGENT); }
        asm volatile("s_waitcnt vmcnt(0)" ::: "memory");
        if (tid < 256 && lane == 0) __hip_atomic_fetch_add(cnt + u.pm, 1u, __ATOMIC_RELAXED, __HIP_MEMORY_SCOPE_AGENT);
        if (wid == 0) { unsigned spins = 0; bool dead = false;
            while ((unsigned)__builtin_amdgcn_readfirstlane((int)__hip_atomic_load(cnt + u.pm, __ATOMIC_RELAXED, __HIP_MEMORY_SCOPE_AGENT)) < 16u) { __builtin_amdgcn_s_sleep(2); if (++spins > (1u << 20)) { dead = true; break; } }
            __builtin_amdgcn_fence(__ATOMIC_ACQUIRE, "agent");
            if (lane == 0) flag[0] = dead ? 1u : 0u; }
        asm volatile("s_waitcnt vmcnt(0) lgkmcnt(0)" ::: "memory"); __builtin_amdgcn_s_barrier(); asm volatile("" ::: "memory");
        if (tid < 256) { const float* sl = xbuf + (size_t)(u.pm * BM + tid) * 4; float t = 0.f;
#pragma unroll
            for (int q = 0; q < 4; ++q) t += __hip_atomic_load(sl + q, __ATOMIC_RELAXED, __HIP_MEMORY_SCOPE_AGENT);
            S[tid] = rsqrtf(t * (1.0f / DM) + EPS); }
        asm volatile("s_waitcnt lgkmcnt(0)" ::: "memory"); __builtin_amdgcn_s_barrier(); asm volatile("" ::: "memory");
        const float* scp = nxsc + (size_t)b * (NMOD * DM); const float* shp = nxsh + (size_t)b * (NMOD * DM);
        f32x4 A4[2][2], B4[2][2];
#pragma unroll
        for (int bj = 0; bj < 2; ++bj)
#pragma unroll
            for (int n = 0; n < 2; ++n) { const int c = col0 + bj * HALF + n * 4; A4[bj][n] = *(const f32x4*)(nxg + c) * (*(const f32x4*)(scp + c) + 1.0f); B4[bj][n] = *(const f32x4*)(shp + c); }
#pragma unroll
        for (int ai = 0; ai < 2; ++ai)
#pragma unroll
            for (int m = 0; m < 4; ++m) { const int rl = ai * HALF + wr * 64 + m * 16 + fr; const float r = S[rl]; bf16_t* up = U + (size_t)(u.pm * BM + rl) * DM + col0;
#pragma unroll
                for (int bj = 0; bj < 2; ++bj) { const f32x4 y0 = acc[ai][bj][m][0] * r * A4[bj][0] + B4[bj][0], y1 = acc[ai][bj][m][1] * r * A4[bj][1] + B4[bj][1];
                    u32x4 w; w.x = cvtpk(y0[0], y0[1]); w.y = cvtpk(y0[2], y0[3]); w.z = cvtpk(y1[0], y1[1]); w.w = cvtpk(y1[2], y1[3]);
                    *(u32x4*)(up + bj * HALF) = w; } }
    }
};
struct EpiCmp {
    static constexpr bool A_NT = false; static constexpr bool PERM = true;
    float* O;
    __device__ __forceinline__ void operator()(const f32x4 (&acc)[2][2][4][2], const Unit& u, int wr, int wc, int fr, int fq) const {
        const bool isv = u.pm >= 16; const int row0 = u.pm * BM + wr * 64 + fr, col0 = wc * 32 + 8 * fq;
        float* ob = O + (size_t)u.pn * 8192 * 128;
#pragma unroll
        for (int ai = 0; ai < 2; ++ai)
#pragma unroll
            for (int m = 0; m < 4; ++m) { float* rowp = ob + (size_t)(row0 + ai * HALF + m * 16) * 128 + col0;
                *(f32x4*)rowp = isv ? acc[ai][1][m][0] : acc[ai][0][m][0]; *(f32x4*)(rowp + 4) = isv ? acc[ai][1][m][1] : acc[ai][0][m][1]; }
    }
};

template <class Epi>
__device__ __forceinline__ void gemm_phase(LAS unsigned char* lds, const Gemm g, const StaticOrder& S, const Epi& E) {
    int tid_ = threadIdx.x; asm volatile("" : "+v"(tid_));
    const int tid = tid_, wid = __builtin_amdgcn_readfirstlane(tid >> 6), lane = tid & 63, wr = wid >> 2, wc = wid & 3, fr = lane & 15, fq = lane >> 4;
    const int K = g.K, nt = K / BK;
    unsigned voffA[2], voffB[2];
#pragma unroll
    for (int i = 0; i < 2; ++i) { int R, C; stage_rc(tid * 16 + i * 8192, R, C); const int Rb = Epi::PERM ? ((R & ~31) + perm32(R & 31)) : R;
        voffA[i] = (unsigned)(R * g.lda + C) * 2u; voffB[i] = (unsigned)(Rb * g.ldb + C) * 2u; }
    const size_t kstep = (size_t)(BK * 2);
    const size_t hstepA = (size_t)HALF * g.lda * 2, hstepB = (size_t)HALF * g.ldb * 2;
    const size_t tstepA = 2 * hstepA, tstepB = 2 * hstepB;
    const unsigned ldsw = (unsigned)wid * 1024u;
    const int aoff = lds_byte(wr * 64 + fr, fq * 8), boff = lds_byte(wc * 32 + fr, fq * 8);
#define PG8_SA(b, h) (((b) * 2 + (h)) * HTB)
#define PG8_SB(b, h) ((4 + (b) * 2 + (h)) * HTB)
#define PG8_STAGE(bufoff, gbase, voff) do { _Pragma("unroll") for (int _i = 0; _i < 2; ++_i) \
        __builtin_amdgcn_global_load_lds((const unsigned*)((const char*)(gbase) + (voff)[_i]), (LAS unsigned*)(lds + (bufoff) + ldsw + _i * 8192), 16, 0, 0); } while (0)
#define PG8_STAGE_A(bufoff, gbase, voff) do { _Pragma("unroll") for (int _i = 0; _i < 2; ++_i) \
        __builtin_amdgcn_global_load_lds((const unsigned*)((const char*)(gbase) + (voff)[_i]), (LAS unsigned*)(lds + (bufoff) + ldsw + _i * 8192), 16, 0, Epi::A_NT ? 2 : 0); } while (0)
#define PG8_LDA(dst, b, h) do { _Pragma("unroll") for (int m = 0; m < 4; ++m) _Pragma("unroll") for (int k = 0; k < 2; ++k) dst[m][k] = *(const LAS bf16x8*)(lds + PG8_SA(b, h) + aoff + m * 2048 + k * 1024); } while (0)
#define PG8_LDB(dst, b, h) do { _Pragma("unroll") for (int n = 0; n < 2; ++n) _Pragma("unroll") for (int k = 0; k < 2; ++k) dst[n][k] = *(const LAS bf16x8*)(lds + PG8_SB(b, h) + boff + n * 2048 + k * 1024); } while (0)
#define PG8_MMA(ai, bj, At, Bt) do { __builtin_amdgcn_s_setprio(1); _Pragma("unroll") for (int m = 0; m < 4; ++m) _Pragma("unroll") for (int n = 0; n < 2; ++n) _Pragma("unroll") for (int k = 0; k < 2; ++k) \
        acc[ai][bj][m][n] = __builtin_amdgcn_mfma_f32_16x16x32_bf16(Bt[n][k], At[m][k], acc[ai][bj][m][n], 0, 0, 0); __builtin_amdgcn_s_setprio(0); } while (0)
#define PG8_WAIT_V(n) asm volatile("s_waitcnt vmcnt(" #n ")" ::: "memory")
#define PG8_WAIT_L(n) asm volatile("s_waitcnt lgkmcnt(" #n ")" ::: "memory")
#define PG8_BAR __builtin_amdgcn_s_barrier()
#define PG8_SCHED __builtin_amdgcn_sched_barrier(0)
    Unit cur, nxt; int ui = 0;
    if (!S.next(0, cur)) return;
    f32x4 acc[2][2][4][2];
#pragma unroll
    for (int a = 0; a < 2; ++a)
#pragma unroll
        for (int b = 0; b < 2; ++b)
#pragma unroll
            for (int m = 0; m < 4; ++m)
#pragma unroll
                for (int n = 0; n < 2; ++n) acc[a][b][m][n] = (f32x4){0.f, 0.f, 0.f, 0.f};
    bf16x8 At[4][2], B0[2][2], B1[2][2];
    const size_t ksb = (size_t)g.ksb, bstep = g.ksb ? ksb : tstepB;
    const char* cA = (const char*)g.A + (size_t)cur.pm * tstepA + (size_t)cur.pn * ksb; const char* cB = (const char*)g.Bt + (size_t)cur.pn * bstep;
    PG8_STAGE(PG8_SB(0, 0), cB, voffB); PG8_STAGE(PG8_SB(0, 1), cB + hstepB, voffB); PG8_STAGE_A(PG8_SA(0, 0), cA, voffA); PG8_STAGE_A(PG8_SA(0, 1), cA + hstepA, voffA);
    if (wr == 1) PG8_BAR;
    PG8_WAIT_V(2); PG8_BAR;
    PG8_STAGE(PG8_SB(1, 0), cB + kstep, voffB); PG8_STAGE_A(PG8_SA(1, 0), cA + kstep, voffA); PG8_STAGE(PG8_SB(1, 1), cB + hstepB + kstep, voffB);
    PG8_WAIT_V(6); PG8_BAR;
    for (;;) {
        const bool has_next = S.next(ui + 1, nxt);
        const char* nA = has_next ? (const char*)g.A + (size_t)nxt.pm * tstepA + (size_t)nxt.pn * ksb : cA; const char* nB = has_next ? (const char*)g.Bt + (size_t)nxt.pn * bstep : cB;
        for (int t = 0; t < nt; t += 2) {
            const bool last = (t == nt - 2);
            const char* a1 = cA + (size_t)(t + 1) * kstep;
            const char* a2 = last ? nA : cA + (size_t)(t + 2) * kstep; const char* b2 = last ? nB : cB + (size_t)(t + 2) * kstep;
            const char* a3 = a2 + kstep; const char* b3 = b2 + kstep;
            PG8_LDB(B0, 0, 0); PG8_LDB(B1, 0, 1); PG8_SCHED; PG8_LDA(At, 0, 0); PG8_STAGE_A(PG8_SA(1, 1), a1 + hstepA, voffA);
            PG8_WAIT_V(8); PG8_WAIT_L(0); PG8_BAR; PG8_MMA(0, 0, At, B0); PG8_MMA(0, 1, At, B1); PG8_BAR; PG8_SCHED;
            PG8_LDA(At, 0, 1); PG8_STAGE(PG8_SB(0, 0), b2, voffB); PG8_STAGE(PG8_SB(0, 1), b2 + hstepB, voffB); PG8_STAGE_A(PG8_SA(0, 0), a2, voffA);
            PG8_WAIT_V(8); PG8_WAIT_L(0); PG8_BAR; PG8_MMA(1, 0, At, B0); PG8_MMA(1, 1, At, B1); PG8_BAR; PG8_SCHED;
            PG8_LDB(B0, 1, 0); PG8_LDB(B1, 1, 1); PG8_SCHED; PG8_LDA(At, 1, 0); PG8_STAGE_A(PG8_SA(0, 1), a2 + hstepA, voffA);
            PG8_WAIT_V(8); PG8_WAIT_L(0); PG8_BAR; PG8_MMA(0, 0, At, B0); PG8_MMA(0, 1, At, B1); PG8_BAR; PG8_SCHED;
            PG8_LDA(At, 1, 1); PG8_STAGE(PG8_SB(1, 0), b3, voffB); PG8_STAGE(PG8_SB(1, 1), b3 + hstepB, voffB); PG8_STAGE_A(PG8_SA(1, 0), a3, voffA);
            PG8_WAIT_V(8); PG8_WAIT_L(0); PG8_BAR; PG8_MMA(1, 0, At, B0); PG8_MMA(1, 1, At, B1); PG8_BAR; PG8_SCHED;
        }
        if (wr == 0) PG8_BAR;
        E(acc, cur, wr, wc, fr, fq);
        if (!has_next) break;
#pragma unroll
        for (int a = 0; a < 2; ++a)
#pragma unroll
            for (int b = 0; b < 2; ++b)
#pragma unroll
                for (int m = 0; m < 4; ++m)
#pragma unroll
                    for (int n = 0; n < 2; ++n) acc[a][b][m][n] = (f32x4){0.f, 0.f, 0.f, 0.f};
        cur = nxt; cA = nA; cB = nB; ++ui;
        if (wr == 1) PG8_BAR;
    }
    PG8_WAIT_V(0);
    PG8_BAR;
#undef PG8_SA
#undef PG8_SB
#undef PG8_STAGE
#undef PG8_STAGE_A
#undef PG8_LDA
#undef PG8_LDB
#undef PG8_MMA
#undef PG8_WAIT_V
#undef PG8_WAIT_L
#undef PG8_BAR
#undef PG8_SCHED
}
}

#define XB_TMO      128
#define XB_XCNT(j)  (256  + 64 * (j))
#define XB_XSUB(j)  (1280 + 64 * (j))
#define XB_XGEN(j)  (2304 + 64 * (j))
#define XB_TOP      3328
#define XB_TOPGEN   3392
#define XCD_BAR_WORDS 3456
#define XB_SPIN_CAP (1u << 18)
__device__ __forceinline__ unsigned xb_ld(unsigned* p)              { return __hip_atomic_load(p, __ATOMIC_RELAXED, __HIP_MEMORY_SCOPE_AGENT); }
__device__ __forceinline__ unsigned xb_add(unsigned* p, unsigned v) { return __hip_atomic_fetch_add(p, v, __ATOMIC_RELAXED, __HIP_MEMORY_SCOPE_AGENT); }
__device__ __forceinline__ unsigned xb_xcc_id() { return (unsigned)__builtin_amdgcn_s_getreg((3 << 11) | 20) & 0xFu; }
#define XB_SPIN(cond, bar) do { unsigned _sp = 0; while (cond) { __builtin_amdgcn_s_sleep(1); \
    if ((++_sp & 255u) == 0u) { if (xb_ld(&(bar)[XB_TMO])) break; if (_sp > XB_SPIN_CAP) { atomicAdd(&(bar)[XB_TMO], 1u); break; } } } } while (0)
struct XcdBarrier { unsigned* bar; unsigned x; volatile LAS unsigned* st; };
__device__ __forceinline__ XcdBarrier xcd_barrier_post(unsigned* bar, volatile LAS unsigned* st) {
    XcdBarrier b; b.bar = bar; b.x = xb_xcc_id(); b.st = st;
    if (threadIdx.x == 0) (void)xb_add(&bar[XB_XCNT(b.x)], 1u);
    return b;
}
__device__ __forceinline__ void xcd_barrier_complete(unsigned* bar, unsigned x, unsigned& nloc, unsigned& nx) {
    const unsigned G = gridDim.x * gridDim.y * gridDim.z;
    unsigned sum, cnt, mine, sp = 0u;
    for (;;) {
        sum = 0u; cnt = 0u; mine = 0u;
#pragma unroll
        for (unsigned j = 0; j < 16; ++j) { const unsigned c = xb_ld(&bar[XB_XCNT(j)]); sum += c; cnt += (c > 0u) ? 1u : 0u; mine = (j == x) ? c : mine; }
        if (sum == G) break;
        __builtin_amdgcn_s_sleep(1);
        if ((++sp & 255u) == 0u) { if (xb_ld(&bar[XB_TMO])) break; if (sp > XB_SPIN_CAP) { atomicAdd(&bar[XB_TMO], 1u); break; } }
    }
    nloc = mine > 0u ? mine : 1u; nx = cnt > 0u ? cnt : 1u;
}
__device__ __forceinline__ void xcd_barrier(const XcdBarrier& b) {
    asm volatile("s_waitcnt vmcnt(0)" ::: "memory");
    __syncthreads();
    if (threadIdx.x == 0) {
        unsigned* bar = b.bar;
        __builtin_amdgcn_s_waitcnt(0);
        unsigned nloc = b.st[0], nx = b.st[1];
        if (nloc == 0u) { xcd_barrier_complete(bar, b.x, nloc, nx); b.st[0] = nloc; b.st[1] = nx; }
        const unsigned old = xb_add(&bar[XB_XSUB(b.x)], 1u);
        const unsigned gen = old / nloc;
        if (old + 1u == (gen + 1u) * nloc) {
            __builtin_amdgcn_fence(__ATOMIC_RELEASE, "agent");
            asm volatile("s_waitcnt vmcnt(0)" ::: "memory");
            const unsigned og = xb_add(&bar[XB_TOP], 1u);
            const unsigned tg = og / nx;
            if (og + 1u == (tg + 1u) * nx) xb_add(&bar[XB_TOPGEN], 1u);
            else XB_SPIN(xb_ld(&bar[XB_TOPGEN]) == tg, bar);
            __builtin_amdgcn_fence(__ATOMIC_ACQUIRE, "agent");
            xb_add(&bar[XB_XGEN(b.x)], 1u);
            asm volatile("s_waitcnt vmcnt(0)" ::: "memory");
        } else {
            XB_SPIN(xb_ld(&bar[XB_XGEN(b.x)]) == gen, bar);
            __builtin_amdgcn_fence(__ATOMIC_ACQUIRE, "agent");
            asm volatile("s_waitcnt vmcnt(0)" ::: "memory");
        }
    }
    __syncthreads();
}

struct Params {
    const float* x; const float* c; const int* pos; const float* ada_w; const float* ada_b; const float* norm_g;
    const float* ffn_w_in; const float* ffn_w_out; const float* w_in; const float* w_out; const float* a_sinks; const float* a_qk_g;
    const float* b_q_lat_g; const float* b_kv_lat_g; const float* b_w_uq; const float* b_w_ukv; const float* b_qk_nope_g; const float* b_qk_rope_g;
    const float* c_qk_g; const float* c_cmp_pe; const float* c_cmp_w1; const float* c_cmp_w2; const float* c_gate_w; const float* c_gate_b;
    float* out; unsigned char* ws; int ph_lo, ph_hi;
};

__device__ __forceinline__ void transpose_item(const float* __restrict__ W, int Nsrc, int src_col0, bf16_t* WT, int K, int dst_row0, int k0, LAS float* scr, int lane, int nvalid = 32) {
    f32x4 v[8];
    if (src_col0 >= 0 && 4 * (lane & 7) < nvalid) {
        const float* wp = W + (size_t)(k0 + (lane >> 3)) * Nsrc + src_col0 + 4 * (lane & 7);
#pragma unroll
        for (int i = 0; i < 8; ++i) v[i] = *(const f32x4*)(wp + (size_t)(8 * i) * Nsrc);
    } else {
#pragma unroll
        for (int i = 0; i < 8; ++i) v[i] = (f32x4){0.f, 0.f, 0.f, 0.f};
    }
#pragma unroll
    for (int i = 0; i < 8; ++i) { LAS float* d = scr + (8 * i + (lane >> 3)) * 33 + 4 * (lane & 7); d[0] = v[i].x; d[1] = v[i].y; d[2] = v[i].z; d[3] = v[i].w; }
    LDS_WAIT();
    const int c = lane & 7;
#pragma unroll
    for (int j = 0; j < 4; ++j) { const int n = (lane >> 3) + 8 * j; const LAS float* s = scr + (8 * c) * 33 + n;
        u32x4 o; o.x = pk2(s[0 * 33], s[1 * 33]); o.y = pk2(s[2 * 33], s[3 * 33]); o.z = pk2(s[4 * 33], s[5 * 33]); o.w = pk2(s[6 * 33], s[7 * 33]);
        *(u32x4*)(WT + (size_t)(dst_row0 + n) * K + k0 + 8 * c) = o; }
    LDS_WAIT();
}
__device__ __forceinline__ int win_src_col(int c) {
    if (c < 512) return c;
    if (c < 1024) return 928 + (c - 512);
    if (c < 1792) return 1440 + (c - 1024);
    if (c < 2048) return 512 + (c - 1792);
    if (c < 2176) return 768 + (c - 2048);
    if (c < 2208) return 896 + (c - 2176);
    if (c < 2272) return 2208 + (c - 2208);
    return -1;
}
__device__ __forceinline__ void prologue(const Params& p, LAS unsigned char* lds, int tid, int wave, int lane, int G) {
    unsigned char* ws = p.ws;
    {
        LAS float* scr = (LAS float*)(lds + wave * 8448);
        const int gw = blockIdx.x * NWAVES + wave, NGW = G * NWAVES;
        constexpr int I1 = 8 * 16 * 176, I2 = 8 * 44 * 32, I3 = 4 * 16 * 72, I4 = 4 * 16 * 32, I5 = 4 * 4 * 16, I6 = 4 * 2 * 16, I7 = 8 * 32 * 4;
        constexpr int NITEMS = I1 + I2 + I3 + I4 + I5 + I6 + I7;
        for (int it = gw; it < NITEMS; it += NGW) {
            int r = it;
            if (r < I1) { const int m = r / 2816, q = r % 2816, kb = q / 176, nb = q % 176, pn = nb >> 3, wi = nb & 7;
                const int src = wi < 4 ? 128 * pn + 32 * wi : DFF + 128 * pn + 32 * (wi - 4);
                transpose_item(p.ffn_w_in + (size_t)m * DM * 2 * DFF, 2 * DFF, src, (bf16_t*)(ws + WS_W1T) + (size_t)m * 2 * DFF * DM, DM, nb * 32, kb * 64, scr, lane); continue; }
            r -= I1;
            if (r < I2) { const int m = r / 1408, q = r % 1408, kb = q / 32, nb = q % 32;
                transpose_item(p.ffn_w_out + (size_t)m * DFF * DM, DM, nb * 32, (bf16_t*)(ws + WS_W2T) + (size_t)m * DM * DFF, DFF, nb * 32, kb * 64, scr, lane); continue; }
            r -= I2;
            if (r < I3) { const int m = r / 1152, q = r % 1152, kb = q / 72, nb = q % 72;
                transpose_item(p.w_in + (size_t)m * DM * DIN, DIN, win_src_col(nb < 56 ? (nb >> 3) * 256 + 64 * (nb & 3) + 32 * ((nb >> 2) & 1) : nb * 32),     (bf16_t*)(ws + WS_WINT) + (size_t)m * DINP * DM, DM, nb * 32, kb * 64, scr, lane); continue; }
            r -= I3;
            if (r < I4) { const int m = r / 512, q = r % 512, kb = q / 32, nb = q % 32;
                transpose_item(p.w_out + (size_t)m * DM * DM, DM, nb * 32, (bf16_t*)(ws + WS_WOUTT) + (size_t)m * DM * DM, DM, nb * 32, kb * 64, scr, lane); continue; }
            r -= I4;
            if (r < I5) { const int m = r / 64, q = r % 64, kb = q / 16, nb = q % 16;
                transpose_item(p.b_w_uq + (size_t)m * 256 * 384, 384, nb < 8 ? 96 * (nb & 3) + 32 * (nb >> 2) : 96 * (nb & 3) + 64 + 16 * ((nb - 8) >> 2), (bf16_t*)(ws + WS_WUQT) + (size_t)m * 512 * 256, 256, nb * 32, kb * 64, scr, lane, nb < 8 ? 32 : 16); continue; }
            r -= I5;
            if (r < I6) { const int m = r / 32, q = r % 32, kb = q / 16, nb = q % 16;
                transpose_item(p.b_w_ukv + (size_t)m * 128 * 512, 512, 128 * (2 * (nb >> 3) + ((nb & 3) >> 1)) + 64 * (nb & 1) + 32 * ((nb >> 2) & 1), (bf16_t*)(ws + WS_WUKVT) + (size_t)m * 512 * 128, 128, nb * 32, kb * 64, scr, lane); continue; }
            r -= I6;
            { const int m = r / 128, q = r % 128, kb = q / 4, nb = q % 4;
                transpose_item(p.c_cmp_w1 + (size_t)m * 2048 * 128, 128, nb * 32, (bf16_t*)(ws + WS_WC1T) + (size_t)(m >> 1) * 256 * 2048, 2048, (m & 1) * 128 + nb * 32, kb * 64, scr, lane); }
        }
    }
    __syncthreads();
    {
        LAS float* cond = (LAS float*)lds;
        LAS float* red = (LAS float*)(lds + 32768);
        for (int i = tid; i < NBATCH * DM; i += NTHREADS) { const float cv = p.c[i]; cond[i] = cv / (1.0f + __expf(-cv)); }
        __syncthreads();
        const int col = tid & 63, ks = tid >> 6;
        float* MOD = (float*)(ws + WS_MOD);
        LAS float* red2 = (LAS float*)(lds + 32768);
        const int c4 = tid & 15, k32 = tid >> 4;
        for (int unit = blockIdx.x; unit < DEPTH * 144; unit += G) {
            const int l = unit / 144, n0 = (unit % 144) * 64;
            const float* Wp = p.ada_w + (size_t)l * DM * (NMOD * DM) + n0 + 4 * c4;
            f32x4 acc[8];
#pragma unroll
            for (int r = 0; r < 8; ++r) acc[r] = (f32x4){0.f, 0.f, 0.f, 0.f};
#pragma unroll 8
            for (int k = k32 * 32; k < k32 * 32 + 32; ++k) { const f32x4 w = *(const f32x4*)(Wp + (size_t)k * (NMOD * DM));
#pragma unroll
                for (int r = 0; r < 8; ++r) acc[r] += w * cond[r * DM + k]; }
#pragma unroll
            for (int r = 0; r < 8; ++r) { LAS float* d = red2 + (k32 * 8 + r) * 64 + 4 * c4; d[0] = acc[r].x; d[1] = acc[r].y; d[2] = acc[r].z; d[3] = acc[r].w; }
            __syncthreads();
            { const int r = tid >> 6; float v = 0.f;
#pragma unroll
              for (int k2 = 0; k2 < 32; ++k2) v += red2[(k2 * 8 + r) * 64 + col];
              MOD[((size_t)l * NBATCH + r) * (NMOD * DM) + n0 + col] = v + p.ada_b[(size_t)l * (NMOD * DM) + n0 + col]; }
            __syncthreads();
        }
        float* CMPBP = (float*)(ws + WS_CMPBP);
        for (int unit = (int)((blockIdx.x + G / 2) % G); unit < 256; unit += G) {
            const int m = unit >> 5, sl = unit & 31, cc = tid & 127, kq = tid >> 7;
            const float* pe = p.c_cmp_pe + (size_t)m * 2048 + sl * 64 + kq * 16; const float* w1 = p.c_cmp_w1 + ((size_t)m * 2048 + sl * 64 + kq * 16) * 128 + cc;
            float a = 0.f;
#pragma unroll
            for (int k = 0; k < 16; ++k) a += pe[k] * w1[(size_t)k * 128];
            red[kq * 128 + cc] = a;
            __syncthreads();
            if (tid < 128) CMPBP[(size_t)unit * 128 + tid] = (red[tid] + red[128 + tid]) + (red[256 + tid] + red[384 + tid]);
            __syncthreads();
        }
    }
    {
        float* C64 = (float*)(ws + WS_COS64); float* S64 = (float*)(ws + WS_SIN64); float* C32 = (float*)(ws + WS_COS32); float* S32 = (float*)(ws + WS_SIN32);
        for (int idx = blockIdx.x * NTHREADS + tid; idx < T * 32; idx += G * NTHREADS) {
            const int tok = idx >> 5, i = idx & 31; const float posf = (float)p.pos[tok];
            { const float inv = 1.0f / powf(10000.0f, (float)(2 * i) / 64.0f); const float ang = posf * inv;
              double rev = (double)ang * 0.15915494309189535; rev -= rint(rev); const float rr = (float)(rev * 6.283185307179586);
              C64[idx] = cosf(rr); S64[idx] = sinf(rr); }
            if (i < 16) { const float inv = 1.0f / powf(10000.0f, (float)(2 * i) / 32.0f); const float ang = posf * inv;
              double rev = (double)ang * 0.15915494309189535; rev -= rint(rev); const float rr = (float)(rev * 6.283185307179586);
              C32[tok * 16 + i] = cosf(rr); S32[tok * 16 + i] = sinf(rr); }
        }
        if (blockIdx.x == 0) { unsigned* z = (unsigned*)(ws + WS_R2 + R2_ZV + 8 * MiB); for (int i = tid; i < 4096; i += NTHREADS) z[i] = 0u; }
    }
}

__device__ __forceinline__ void norm_phase(const float* hin, bf16_t* U, const float* g, const float* modl, int sc_i, int sh_i, int gw, int ngw, int lane) {
    const int b = gw & 7, r0 = gw >> 3, rs = ngw >> 3;
    const float* scp = modl + (size_t)b * (NMOD * DM) + sc_i * DM; const float* shp = modl + (size_t)b * (NMOD * DM) + sh_i * DM;
    f32x4 A[4], B[4];
#pragma unroll
    for (int j = 0; j < 4; ++j) { const int col = 4 * lane + 256 * j; A[j] = *(const f32x4*)(g + col) * (*(const f32x4*)(scp + col) + 1.0f); B[j] = *(const f32x4*)(shp + col); }
    f32x4 v[4], nv[4], mv[4];
    if (r0 < SEQ) { const f32x4* xr = (const f32x4*)(hin + (size_t)(b * SEQ + r0) * DM) + lane;
#pragma unroll
        for (int j = 0; j < 4; ++j) v[j] = xr[64 * j]; }
    if (r0 + rs < SEQ) { const f32x4* xr = (const f32x4*)(hin + (size_t)(b * SEQ + r0 + rs) * DM) + lane;
#pragma unroll
        for (int j = 0; j < 4; ++j) nv[j] = xr[64 * j]; }
    for (int r = r0; r < SEQ; r += rs) {
        const int row = b * SEQ + r;
        if (r + 2 * rs < SEQ) { const f32x4* xr = (const f32x4*)(hin + (size_t)(row + 2 * rs) * DM) + lane;
#pragma unroll
            for (int j = 0; j < 4; ++j) mv[j] = xr[64 * j]; }
        float ss = 0.f;
#pragma unroll
        for (int j = 0; j < 4; ++j) ss += (v[j].x * v[j].x + v[j].y * v[j].y) + (v[j].z * v[j].z + v[j].w * v[j].w);
        const float rr = rsqrtf(wave_sum(ss) * (1.0f / DM) + EPS);
#pragma unroll
        for (int j = 0; j < 4; ++j) { const f32x4 y = (v[j] * rr) * A[j] + B[j];
            u32x2 w; w.x = cvtpk(y.x, y.y); w.y = cvtpk(y.z, y.w);
            *(u32x2*)(U + (size_t)row * DM + 4 * lane + 256 * j) = w; }
#pragma unroll
        for (int j = 0; j < 4; ++j) { v[j] = nv[j]; nv[j] = mv[j]; }
    }
}

__device__ __forceinline__ void unpack4(const u32x2 r, float (&f)[4]) { f[0] = __builtin_bit_cast(float, r.x << 16); f[1] = __builtin_bit_cast(float, r.x & 0xffff0000u); f[2] = __builtin_bit_cast(float, r.y << 16); f[3] = __builtin_bit_cast(float, r.y & 0xffff0000u); }
__device__ __forceinline__ u32x2 pack4(const float (&f)[4]) { u32x2 w; w.x = cvtpk(f[0], f[1]); w.y = cvtpk(f[2], f[3]); return w; }
__device__ __forceinline__ float sumsq8(const float (&a)[4], const float (&b)[4]) { return ((a[0] * a[0] + a[1] * a[1]) + (a[2] * a[2] + a[3] * a[3])) + ((b[0] * b[0] + b[1] * b[1]) + (b[2] * b[2] + b[3] * b[3])); }
__device__ __forceinline__ void load4g(const float* g, float (&o)[4]) { const f32x4 t = *(const f32x4*)g; o[0] = t.x; o[1] = t.y; o[2] = t.z; o[3] = t.w; }
__device__ __forceinline__ void ones4(float (&o)[4]) { o[0] = 1.f; o[1] = 1.f; o[2] = 1.f; o[3] = 1.f; }
__device__ __forceinline__ void scale_rope(float (&a)[4], float (&b)[4], float r, const float (&ga)[4], const float (&gb)[4], bool rope, const f32x4& cs, const f32x4& sn) {
#pragma unroll
    for (int e = 0; e < 4; ++e) { const float ya = a[e] * r * ga[e], yb = b[e] * r * gb[e];
        a[e] = rope ? ya * cs[e] - yb * sn[e] : ya; b[e] = rope ? yb * cs[e] + ya * sn[e] : yb; }
}
__device__ __forceinline__ void postproc_a2(const Params& p, LAS unsigned char* lds, int l, int gw, int ngw, int lane) {
    unsigned char* ws = p.ws; unsigned char* r2 = ws + WS_R2;
    const bf16_t* P2 = (const bf16_t*)(ws + WS_R1);
    bf16_t *CQN = (bf16_t*)(r2 + R2_CQN), *CKVN = (bf16_t*)(r2 + R2_CKVN), *KPE = (bf16_t*)(r2 + R2_KPE);
    float* GATES = (float*)(r2 + R2_GATES);
    const float* C32 = (const float*)(ws + WS_COS32); const float* S32 = (const float*)(ws + WS_SIN32);
    const int j = lane & 7, j4 = lane & 3;
    const int kind = lane < 32 ? 0 : (lane < 48 ? 1 : (lane < 52 ? 2 : (lane < 60 ? 3 : 4)));
    const int offA = kind == 0 ? 64 * (lane >> 3) + 4 * j : (kind == 1 ? 256 + 64 * ((lane - 32) >> 3) + 4 * j : (kind == 2 ? 384 + 4 * j4 : (kind == 3 ? 416 + 8 * (lane - 52) : 480)));
    const int offB = kind <= 1 ? offA + 32 : (kind == 2 ? offA + 16 : offA + 4);
    float ga[4], gb[4];
    if (kind == 0) { const float* gp = p.b_q_lat_g + l * 256 + offA; load4g(gp, ga); load4g(gp + 32, gb); }
    else if (kind == 1) { const float* gp = p.b_kv_lat_g + l * 128 + (offA - 256); load4g(gp, ga); load4g(gp + 32, gb); }
    else if (kind == 2) { const float* gp = p.b_qk_rope_g + (l * 2 + 1) * 32 + 4 * j4; load4g(gp, ga); load4g(gp + 16, gb); }
    else { ones4(ga); ones4(gb); }
    bf16_t* dst = kind == 0 ? CQN + offA : (kind == 1 ? CKVN + (offA - 256) : KPE + 4 * j4); const int ts = kind == 0 ? 256 : (kind == 1 ? 128 : 32), bo = kind == 2 ? 16 : 32;
    const int jj = lane < 24 ? lane : 23;
    LAS float* gwl = (LAS float*)lds;
    __syncthreads();
    { int t_ = threadIdx.x; asm volatile("" : "+v"(t_)); for (int i = t_; i < 64 * 24; i += NTHREADS) gwl[i] = p.c_gate_w[(size_t)l * 64 * 24 + i]; }
    __syncthreads();
    const float gbias = p.c_gate_b[l * 24 + jj];
    u32x2 ra, rb, na, nb;
    if (gw < T) { ra = *(const u32x2*)(P2 + (size_t)gw * 512 + offA); rb = *(const u32x2*)(P2 + (size_t)gw * 512 + offB); }
    for (int tok = gw; tok < T; tok += ngw) {
        if (tok + ngw < T) { na = *(const u32x2*)(P2 + (size_t)(tok + ngw) * 512 + offA); nb = *(const u32x2*)(P2 + (size_t)(tok + ngw) * 512 + offB); }
        const f32x4 cs32 = *(const f32x4*)(C32 + (size_t)tok * 16 + 4 * j4), sn32 = *(const f32x4*)(S32 + (size_t)tok * 16 + 4 * j4);
        float a[4], bb[4];
        unpack4(ra, a); unpack4(rb, bb);
        float ss = sumsq8(a, bb); ss += __shfl_xor(ss, 1); ss += __shfl_xor(ss, 2);
        float s16 = ss; s16 += __shfl_xor(s16, 4); s16 += __shfl_xor(s16, 8);
        float s32 = s16; s32 += __shfl_xor(s32, 16);
        float sg[8];
#pragma unroll
        for (int e = 0; e < 4; ++e) { sg[e] = silu_f(a[e]); sg[4 + e] = silu_f(bb[e]); }
        const float r = kind == 0 ? rsqrtf(s32 * (1.0f / 256) + EPS) : (kind == 1 ? rsqrtf(s16 * (1.0f / 128) + EPS) : rsqrtf(ss * (1.0f / 32) + EPS));
        scale_rope(a, bb, r, ga, gb, kind == 2, cs32, sn32);
        if (kind <= 2) { bf16_t* d = dst + (size_t)tok * ts; *(u32x2*)d = pack4(a); *(u32x2*)(d + bo) = pack4(bb); }
        float acc = gbias;
#pragma unroll
        for (int k = 0; k < 64; ++k) acc += __builtin_bit_cast(float, __builtin_amdgcn_readlane(__builtin_bit_cast(int, sg[k & 7]), 52 + (k >> 3))) * gwl[k * 24 + jj];
        if (lane < 24) GATES[(size_t)tok * 24 + lane] = 1.0f / (1.0f + __expf(-acc));
        ra = na; rb = nb;
    }
}

__device__ __forceinline__ void postproc_b(const Params& p, LAS unsigned char* lds, int l, int gw, int ngw, int lane) {
    unsigned char* ws = p.ws; unsigned char* r1 = ws + WS_R1; unsigned char* r2 = ws + WS_R2;
    bf16_t *KCMP = (bf16_t*)(r2 + R2_KCMP), *VCMP = (bf16_t*)(r2 + R2_VCMP);
    const float* HIDP = (const float*)(r1 + R1_HIDP); const float* CMPB = (const float*)(ws + WS_CMPB);
    const float gck = p.c_qk_g[(l * 4 + 1) * 64 + lane];
    LAS float* w2l = (LAS float*)lds;
    __syncthreads();
    { int t_ = threadIdx.x; asm volatile("" : "+v"(t_)); const f32x4* src = (const f32x4*)(p.c_cmp_w2 + (size_t)l * 2 * 128 * 64);
      for (int i = t_; i < 2 * 128 * 64 / 4; i += NTHREADS) ((LAS f32x4*)w2l)[i] = src[i]; }
    __syncthreads();
    for (int r = gw; r < 8192; r += ngw) {
        const int kv = r >> 12, rr = r & 4095, i = rr & 255;
        const LAS float* w2 = w2l + kv * 128 * 64 + lane;
        float hs0 = CMPB[(l * 2 + kv) * 128 + lane], hs1 = CMPB[(l * 2 + kv) * 128 + 64 + lane];
#pragma unroll
        for (int sl = 0; sl < 4; ++sl) { hs0 += HIDP[((size_t)sl * 8192 + r) * 128 + lane]; hs1 += HIDP[((size_t)sl * 8192 + r) * 128 + 64 + lane]; }
        const int h0 = __builtin_bit_cast(int, bf2f(f2bf(silu_f(hs0)))), h1 = __builtin_bit_cast(int, bf2f(f2bf(silu_f(hs1))));
        float a = 0.f;
#pragma unroll
        for (int k = 0; k < 64; ++k) a += __builtin_bit_cast(float, __builtin_amdgcn_readlane(h0, k)) * w2[k * 64];
#pragma unroll
        for (int k = 0; k < 64; ++k) a += __builtin_bit_cast(float, __builtin_amdgcn_readlane(h1, k)) * w2[(64 + k) * 64];
        if (kv == 0) { float y = a * rsqrtf(wave_sum(a * a) * (1.0f / 64) + EPS) * gck; if (i == 255) y = 0.f; KCMP[(size_t)rr * 64 + lane] = (bf16_t)f2bf(y); }
        else { if (i == 255) a = 0.f; VCMP[(size_t)rr * 64 + lane] = (bf16_t)f2bf(a); }
    }
}

constexpr int AL_K = 0, AL_V = 13312, AL_BUF = 22528, AL_IMP = 4 * 22528, AL_UNI = 4 * 22528 + 33280;
#define MFMA16(a, b, c) __builtin_amdgcn_mfma_f32_16x16x32_bf16((a), (b), (c), 0, 0, 0)

template <int NC>
__device__ __forceinline__ void attn_s_pair(const LAS unsigned char* Ks, const bf16x8 (&q0)[NC], const bf16x8 (&q1)[NC], f32x4 (&s)[2][4], int fr, int fq, float i0 = 0.f, float i1 = 0.f) {
    constexpr int PITCHB = (32 * NC + 8) * 2;
#pragma unroll
    for (int kb = 0; kb < 4; ++kb) {
        s[0][kb] = (f32x4){i0, i0, i0, i0}; s[1][kb] = (f32x4){i1, i1, i1, i1};
#pragma unroll
        for (int c = 0; c < NC; ++c) {
            const bf16x8 kf = *(const LAS bf16x8*)(Ks + (16 * kb + fr) * PITCHB + (32 * c + 8 * fq) * 2);
            s[0][kb] = MFMA16(kf, q0[c], s[0][kb]); s[1][kb] = MFMA16(kf, q1[c], s[1][kb]);
        }
    }
}
typedef short v4i16_t __attribute__((ext_vector_type(4)));
__device__ __forceinline__ bf16x4 vtr_read(const LAS unsigned char* p) { return __builtin_bit_cast(bf16x4, __builtin_amdgcn_ds_read_tr16_b64_v4i16((LAS v4i16_t*)p)); }
__device__ __forceinline__ void attn_pv_pair(const LAS unsigned char* Vs, const bf16x8 (&pf)[2][2], f32x4 (&o0)[4], f32x4 (&o1)[4], int fr, int fq) {
    const LAS unsigned char* vb = Vs + (4 * fq + (fr >> 2)) * 144 + 8 * (fr & 3);
#pragma unroll
    for (int db = 0; db < 4; ++db)
#pragma unroll
        for (int kc = 0; kc < 2; ++kc) {
            const bf16x4 lo = vtr_read(vb + (32 * kc) * 144 + 32 * db), hi = vtr_read(vb + (32 * kc + 16) * 144 + 32 * db);
            const bf16x8 vf = {lo.x, lo.y, lo.z, lo.w, hi.x, hi.y, hi.z, hi.w};
            o0[db] = MFMA16(vf, pf[0][kc], o0[db]); o1[db] = MFMA16(vf, pf[1][kc], o1[db]);
        }
}
__device__ __forceinline__ bf16x8 pack_p(const f32x4& a, const f32x4& b) {
    u32x4 w; w.x = cvtpk(a[0], a[1]); w.y = cvtpk(a[2], a[3]); w.z = cvtpk(b[0], b[1]); w.w = cvtpk(b[2], b[3]); return __builtin_bit_cast(bf16x8, w);
}
template <int NC>
__device__ __forceinline__ void tile_load(const bf16_t* Kb, const bf16_t* Vb, int t, u32x4& k0, u32x4& k1, u32x4& v, int tid, bool withV) {
    const unsigned ko = (unsigned)t * (64u * 32u * NC) + (unsigned)tid * 8u, vo = (unsigned)t * 4096u + (unsigned)tid * 8u;
    k0 = *(const u32x4*)(Kb + ko);
    if (NC == 3) { if (tid < 256) k1 = *(const u32x4*)(Kb + ko + 4096u); }
    if (withV) v = *(const u32x4*)(Vb + vo);
}
template <int NC>
__device__ __forceinline__ void tile_store(LAS unsigned char* lds, const u32x4& k0, const u32x4& k1, const u32x4& v, int tid, bool withV) {
    constexpr int CPK = 4 * NC, PITCHB = (32 * NC + 8) * 2;
    { const int key = tid / CPK, ch = tid % CPK; *(LAS u32x4*)(lds + AL_K + key * PITCHB + ch * 16) = k0; }
    if (NC == 3) { if (tid < 256) { const int cid = tid + 512, key = cid / CPK, ch = cid % CPK; *(LAS u32x4*)(lds + AL_K + key * PITCHB + ch * 16) = k1; } }
    if (withV) { const int key = tid >> 3, ch = tid & 7; *(LAS u32x4*)(lds + AL_V + key * 144 + ch * 16) = v; }
}

struct AttnPtrs { const bf16_t* Q; const bf16_t* K; const bf16_t* V; bf16_t* O; int ldo, col0; float c2, shiftC; const float* sinks; const unsigned long long* sel; const float* gates; const bf16_t* ocmp; const bf16_t* K2; const bf16_t* V2; float shift2; };
template <int MODE> struct ACfg;
template <> struct ACfg<0> { static constexpr int NC = 2, G = 2, H = 4, HKV = 2; };
template <> struct ACfg<1> { static constexpr int NC = 3, G = 1, H = 4, HKV = 4; };
template <> struct ACfg<2> { static constexpr int NC = 2, G = 4, H = 8, HKV = 2; };
template <> struct ACfg<3> { static constexpr int NC = 2, G = 4, H = 8, HKV = 2; };

template <int MODE, int SM>
__device__ __forceinline__ void attn_tile(const LAS unsigned char* Kl, const LAS unsigned char* Vl, const bf16x8 (&qf)[2][ACfg<MODE>::NC], f32x4 (&o)[2][4], f32x4 (&lacc)[2],
                                          int kt, int qw0, int fr, int fq, float shiftC, bool masked, unsigned selbits) {
    constexpr int NC = ACfg<MODE>::NC, G = ACfg<MODE>::G;
    f32x4 s[2][4];
    attn_s_pair<NC>(Kl, qf[0], qf[1], s, fr, fq, (selbits & 1u) ? -shiftC : -INFINITY, (selbits & 2u) ? -shiftC : -INFINITY);
    bf16x8 pf[2][2];
    const u32x4 onesw = {0x3f803f80u, 0x3f803f80u, 0x3f803f80u, 0x3f803f80u}; const bf16x8 ones = __builtin_bit_cast(bf16x8, onesw);
#pragma unroll
    for (int g = 0; g < 2; ++g) {
        if (masked) {
            const int qpos = (MODE == 3) ? qw0 + 4 * g + (fr >> 2) : qw0 + (G == 1 ? 16 * g : 0) + fr;
#pragma unroll
            for (int kb = 0; kb < 4; ++kb)
#pragma unroll
                for (int e = 0; e < 4; ++e) { const int key = 64 * kt + 16 * kb + 4 * fq + e; bool valid;
                    if (SM == 0) valid = (key <= qpos) && (key > qpos - 128);
                    else if (SM == 2) valid = (key <= qpos) && (key > qpos - 256);
                    else valid = key <= qpos;
                    s[g][kb][e] = valid ? s[g][kb][e] : -INFINITY; }
        }
#pragma unroll
        for (int kb = 0; kb < 4; ++kb)
#pragma unroll
            for (int e = 0; e < 4; ++e) s[g][kb][e] = fast_exp2(s[g][kb][e]);
        pf[g][0] = pack_p(s[g][0], s[g][1]); pf[g][1] = pack_p(s[g][2], s[g][3]);
        lacc[g] = MFMA16(ones, pf[g][0], lacc[g]); lacc[g] = MFMA16(ones, pf[g][1], lacc[g]);
    }
    attn_pv_pair(Vl, pf, o[0], o[1], fr, fq);
}

template <int MODE, int SM>
__device__ __forceinline__ void attn_stream(LAS unsigned char* lds, const bf16_t* Kb, const bf16_t* Vb, const bf16x8 (&qf)[2][ACfg<MODE>::NC], f32x4 (&o)[2][4], f32x4 (&lacc)[2],
                                            const unsigned long long* selp, int q0, int qw0, int qt, float sh_loc, int tid, int w, int lane, int fr, int fq) {
    typedef ACfg<MODE> C; constexpr int NC = C::NC, G = C::G;
    constexpr int QW = (MODE == 3) ? 8 : ((G == 1) ? 32 : 16), UQ = (G == 1) ? 256 : (G == 2 ? 128 : 64);
    int kt_lo = 0, kt_hi = 0; unsigned long long rem = 0ull, wuni = 0ull; unsigned s0lo = 0u, s0hi = 0u, s1lo = 0u, s1hi = 0u;
    if (SM == 0) { kt_lo = (q0 - 127) < 0 ? 0 : (q0 - 127) >> 6; kt_hi = (q0 + UQ - 1) >> 6; }
    if (SM == 1) { kt_lo = 0; kt_hi = (q0 + UQ - 1) >> 6; }
    if (SM == 2) { kt_lo = (q0 - 255) < 0 ? 0 : (q0 - 255) >> 6; kt_hi = (q0 + UQ - 1) >> 6; }
    __syncthreads();
    if (SM == 3) {
        const unsigned long long sel = selp[qw0 + (fr >> 2)], sel1 = selp[qw0 + 4 + (fr >> 2)];
        s0lo = (unsigned)sel; s0hi = (unsigned)(sel >> 32); s1lo = (unsigned)sel1; s1hi = (unsigned)(sel1 >> 32);
        unsigned lo = s0lo | s1lo, hi = s0hi | s1hi;
#pragma unroll
        for (int off = 4; off < 16; off <<= 1) { lo |= __shfl_xor(lo, off); hi |= __shfl_xor(hi, off); }
        wuni = ((unsigned long long)(unsigned)__builtin_amdgcn_readfirstlane((int)hi) << 32) | (unsigned)__builtin_amdgcn_readfirstlane((int)lo);
        LAS unsigned* un = (LAS unsigned*)(lds + AL_UNI);
        if (lane == 0) { un[2 * w] = lo; un[2 * w + 1] = hi; }
        __syncthreads();
        unsigned ulo = 0, uhi = 0;
#pragma unroll
        for (int j = 0; j < 8; ++j) { ulo |= un[2 * j]; uhi |= un[2 * j + 1]; }
        rem = ((unsigned long long)(unsigned)__builtin_amdgcn_readfirstlane((int)uhi) << 32) | (unsigned)__builtin_amdgcn_readfirstlane((int)ulo);
    }
#define NEXT_TILE(dst, cur) do { if (SM == 3) { dst = rem ? (int)__builtin_ctzll(rem) : -1; rem &= rem - 1; } else dst = ((cur) >= 0 && (cur) < kt_hi) ? (cur) + 1 : -1; } while (0)
#define TILE_LOAD(t, K0, K1, V0) tile_load<NC>(Kb, Vb, (t), K0, K1, V0, tid, true)
#define TILE_COMPUTE(t, bufoff) do { \
        bool need_, full_; \
        if (SM == 0) { need_ = (64 * (t) + 63 > qw0 - 128) && (64 * (t) <= qw0 + QW - 1); full_ = (64 * (t) + 63 <= qw0) && (64 * (t) > qw0 + QW - 1 - 128); } \
        else if (SM == 1) { need_ = 64 * (t) <= qw0 + QW - 1; full_ = 64 * (t) + 63 <= qw0; } \
        else if (SM == 2) { need_ = (64 * (t) + 63 > qw0 - 256) && (64 * (t) <= qw0 + QW - 1); full_ = (64 * (t) + 63 <= qw0) && (64 * (t) > qw0 + QW - 1 - 256); } \
        else { need_ = ((wuni >> (t)) & 1ull) != 0ull; full_ = (t) != qt; }     \
        if (need_) { const unsigned selbit_ = (SM == 3) ? ((((((t) & 32) ? s0hi : s0lo) >> ((t) & 31)) & 1u) | ((((((t) & 32) ? s1hi : s1lo) >> ((t) & 31)) & 1u) << 1)) : 3u; \
            if (full_) attn_tile<MODE, SM>(lds + (bufoff) + AL_K, lds + (bufoff) + AL_V, qf, o, lacc, (t), qw0, fr, fq, sh_loc, false, selbit_); \
            else attn_tile<MODE, SM>(lds + (bufoff) + AL_K, lds + (bufoff) + AL_V, qf, o, lacc, (t), qw0, fr, fq, sh_loc, true, selbit_); } } while (0)
    int tq[6];
    if (SM == 3) { tq[0] = rem ? (int)__builtin_ctzll(rem) : -1; rem &= rem - 1; } else tq[0] = kt_lo;
#pragma unroll
    for (int k = 1; k < 4; ++k) NEXT_TILE(tq[k], tq[k - 1]);
    u32x4 rk0[2], rk1[2], rv[2];
    rk1[0] = (u32x4){0u, 0u, 0u, 0u}; rk1[1] = rk1[0];
#define LOADSET(u, t) do { const int tl_ = (t) < 0 ? 0 : (t); TILE_LOAD(tl_, rk0[u], rk1[u], rv[u]); } while (0)
    if (tq[0] >= 0) {
        LOADSET(0, tq[0]); LOADSET(1, tq[1]);
        tile_store<NC>(lds, rk0[0], rk1[0], rv[0], tid, true); tile_store<NC>(lds + AL_BUF, rk0[1], rk1[1], rv[1], tid, true);
        LOADSET(0, tq[2]); LOADSET(1, tq[3]);
        __syncthreads();
        for (;;) {
#pragma unroll
            for (int u = 0; u < 2; ++u) {
                const int cur = u ? 2 * AL_BUF : 0, nxt = u ? 0 : 2 * AL_BUF;
                tile_store<NC>(lds + nxt, rk0[0], rk1[0], rv[0], tid, true); tile_store<NC>(lds + nxt + AL_BUF, rk0[1], rk1[1], rv[1], tid, true);
                NEXT_TILE(tq[4], tq[3]); NEXT_TILE(tq[5], tq[4]);
                LOADSET(0, tq[4]); LOADSET(1, tq[5]);
                TILE_COMPUTE(tq[0], cur);
                if (tq[1] >= 0) TILE_COMPUTE(tq[1], cur + AL_BUF);
                __syncthreads();
#pragma unroll
                for (int k = 0; k < 4; ++k) tq[k] = tq[k + 2];
                if (tq[0] < 0) break;
            }
            if (tq[0] < 0) break;
        }
    }
#undef LOADSET
#undef NEXT_TILE
#undef TILE_LOAD
#undef TILE_COMPUTE
}

template <int MODE>
__device__ __forceinline__ void attn_flash(LAS unsigned char* lds, const AttnPtrs& a, int b, int hkv, int qt) {
    typedef ACfg<MODE> C; constexpr int NC = C::NC, G = C::G, DQ = 32 * NC;
    constexpr int QW = (G == 1) ? 32 : 16, UQ = (G == 1) ? 256 : (G == 2 ? 128 : 64);
    const float sh_loc = uniform_f(a.shiftC), sh2_loc = uniform_f(a.shift2); const int ldo_loc = __builtin_amdgcn_readfirstlane(a.ldo), col0_loc = __builtin_amdgcn_readfirstlane(a.col0);
    int tid_ = threadIdx.x; asm volatile("" : "+v"(tid_));
    const int tid = tid_, w = __builtin_amdgcn_readfirstlane(tid >> 6), lane = tid & 63, fr = lane & 15, fq = lane >> 4;
    const int q0 = qt * UQ, qw0 = q0 + (MODE == 3 ? 8 * w : QW * w);
    const int hbase = hkv * G;
    bf16x8 qf[2][NC];
#pragma unroll
    for (int i = 0; i < 2; ++i) { const int h = (MODE == 3) ? hkv * 4 + (fr & 3) : hbase + (G == 1 ? 0 : i), q = (MODE == 3) ? qw0 + 4 * i + (fr >> 2) : qw0 + (G == 1 ? 16 * i : 0) + fr;
        const bf16_t* qp = a.Q + ((size_t)(b * C::H + h) * SEQ + q) * DQ + 8 * fq;
#pragma unroll
        for (int c = 0; c < NC; ++c) qf[i][c] = *(const bf16x8*)(qp + 32 * c); }
    f32x4 o[2][4], lacc[2], ow[2][4], lw[2];
#pragma unroll
    for (int i = 0; i < 2; ++i) { lacc[i] = (f32x4){0.f, 0.f, 0.f, 0.f}; lw[i] = lacc[i];
#pragma unroll
        for (int d = 0; d < 4; ++d) { o[i][d] = (f32x4){0.f, 0.f, 0.f, 0.f}; ow[i][d] = o[i][d]; } }
    const size_t kvo = (size_t)(b * C::HKV + hkv) * SEQ;
    if (MODE == 3) attn_stream<MODE, 2>(lds, a.K2 + kvo * DQ, a.V2 + kvo * 64, qf, ow, lw, nullptr, q0, qw0, qt, sh2_loc, tid, w, lane, fr, fq);
    attn_stream<MODE, MODE>(lds, a.K + kvo * DQ, a.V + kvo * 64, qf, o, lacc, MODE == 3 ? a.sel + (size_t)(b * 2 + hkv) * SEQ : nullptr, q0, qw0, qt, sh_loc, tid, w, lane, fr, fq);
#pragma unroll
    for (int i = 0; i < 2; ++i) {
        const int hl = (MODE == 3) ? hkv * 4 + (fr & 3) : hbase + (G == 1 ? 0 : i), q = (MODE == 3) ? qw0 + 4 * i + (fr >> 2) : qw0 + (G == 1 ? 16 * i : 0) + fr;
        float lt = lacc[i][0];
        if (MODE == 0) { const float* sp_ = a.sinks; asm volatile("" : "+s"(sp_)); lt += fast_exp2(sp_[hl] * LOG2E - sh_loc); }
        const float inv = lt > 0.f ? 1.0f / lt : 0.f;
        const size_t tok = (size_t)b * SEQ + q;
        float g0 = 0.f, g1 = 0.f, g2 = 0.f;
        if (MODE == 3) { const float* gp = a.gates + tok * 24 + 3 * hl; const float lwv = lw[i][0]; g0 = gp[0]; g1 = gp[1] * inv; g2 = lwv > 0.f ? gp[2] / lwv : 0.f; }
#pragma unroll
        for (int db = 0; db < 4; ++db) {
            f32x4 v;
            const int col = 64 * hl + 16 * db + 4 * fq;
            if (MODE == 3) {
                const u32x2 c2_ = *(const u32x2*)(a.ocmp + tok * 512 + col);
                v[0] = g0 * bf2f(c2_.x & 0xffffu) + g1 * o[i][db][0] + g2 * ow[i][db][0];
                v[1] = g0 * bf2f(c2_.x >> 16) + g1 * o[i][db][1] + g2 * ow[i][db][1];
                v[2] = g0 * bf2f(c2_.y & 0xffffu) + g1 * o[i][db][2] + g2 * ow[i][db][2];
                v[3] = g0 * bf2f(c2_.y >> 16) + g1 * o[i][db][3] + g2 * ow[i][db][3];
            } else v = o[i][db] * inv;
            u32x2 wv; wv.x = cvtpk(v[0], v[1]); wv.y = cvtpk(v[2], v[3]);
            *(u32x2*)(a.O + tok * ldo_loc + col0_loc + col) = wv;
        }
    }
}

__device__ __forceinline__ void attn_cmp(LAS unsigned char* lds, const bf16_t* QC, const bf16_t* KCMP, const bf16_t* VCMP, bf16_t* OCMP, unsigned long long* SEL, float shiftC, int b, int hkv, int qt) {
    constexpr int NC = 2;
    int tid_ = threadIdx.x; asm volatile("" : "+v"(tid_));
    const int tid = tid_, w = __builtin_amdgcn_readfirstlane(tid >> 6), lane = tid & 63, fr = lane & 15, fq = lane >> 4;
    const int q0 = qt * 64, qw0 = q0 + 16 * (w >> 1), qpos = qw0 + fr, hbase = hkv * 4 + 2 * (w & 1);
    const float sh = uniform_f(shiftC);
    bf16x8 qf[2][NC];
#pragma unroll
    for (int i = 0; i < 2; ++i) { const bf16_t* qp = QC + ((size_t)(b * 8 + hbase + i) * SEQ + qpos) * 64 + 8 * fq;
#pragma unroll
        for (int c = 0; c < NC; ++c) qf[i][c] = *(const bf16x8*)(qp + 32 * c); }
    const bf16_t* Kb = KCMP + (size_t)(b * 2 + hkv) * 256 * 64; const bf16_t* Vb = VCMP + (size_t)(b * 2 + hkv) * 256 * 64;
    const int jb = q0 + 63 - 31;
    const int nt = ((jb >> 4) >> 6) + 1;
    const int jw = qw0 + 15 - 31;
    const int ntw = jw < 0 ? 0 : ((jw >> 4) >> 6) + 1;
    u32x4 kr[4], vr[4], dummy = (u32x4){0u, 0u, 0u, 0u};
#pragma unroll
    for (int kt = 0; kt < 4; ++kt) { const int tl = kt < nt ? kt : 0; tile_load<NC>(Kb, Vb, tl, kr[kt], dummy, vr[kt], tid, true); }
    __syncthreads();
#pragma unroll
    for (int kt = 0; kt < 4; ++kt) tile_store<NC>(lds + kt * AL_BUF, kr[kt], dummy, vr[kt], tid, true);
    LAS float* imp = (LAS float*)(lds + AL_IMP) + w * (16 * 65);
    for (int i = lane; i < 16 * 65; i += 64) imp[i] = 0.f;
    __syncthreads();
    f32x4 o[2][4], lacc[2];
#pragma unroll
    for (int i = 0; i < 2; ++i) { lacc[i] = (f32x4){0.f, 0.f, 0.f, 0.f};
#pragma unroll
        for (int d = 0; d < 4; ++d) o[i][d] = (f32x4){0.f, 0.f, 0.f, 0.f}; }
    float va[2][4][4], vb[2][4][4];
#pragma unroll
    for (int g = 0; g < 2; ++g)
#pragma unroll
        for (int kt = 0; kt < 4; ++kt)
#pragma unroll
            for (int kb = 0; kb < 4; ++kb) { va[g][kt][kb] = 0.f; vb[g][kt][kb] = 0.f; }
    const u32x4 onesw = {0x3f803f80u, 0x3f803f80u, 0x3f803f80u, 0x3f803f80u}; const bf16x8 ones = __builtin_bit_cast(bf16x8, onesw);
#pragma unroll
    for (int kt = 0; kt < 4; ++kt) {
        if (kt < ntw) {
            f32x4 s[2][4];
            attn_s_pair<NC>(lds + kt * AL_BUF + AL_K, qf[0], qf[1], s, fr, fq, -sh, -sh);
            bf16x8 pf[2][2];
#pragma unroll
            for (int g = 0; g < 2; ++g) {
#pragma unroll
                for (int kb = 0; kb < 4; ++kb) {
#pragma unroll
                    for (int e = 0; e < 4; ++e) { const int j = 64 * kt + 16 * kb + 4 * fq + e; const bool valid = (16 * j + 31 <= qpos) && (j < 255);
                        s[g][kb][e] = fast_exp2(valid ? s[g][kb][e] : -INFINITY); }
                    va[g][kt][kb] = (s[g][kb][0] + s[g][kb][1]) + (s[g][kb][2] + s[g][kb][3]); vb[g][kt][kb] = s[g][kb][3]; }
                pf[g][0] = pack_p(s[g][0], s[g][1]); pf[g][1] = pack_p(s[g][2], s[g][3]);
                lacc[g] = MFMA16(ones, pf[g][0], lacc[g]); lacc[g] = MFMA16(ones, pf[g][1], lacc[g]); }
            attn_pv_pair(lds + kt * AL_BUF + AL_V, pf, o[0], o[1], fr, fq);
        }
    }
    float invl[2];
#pragma unroll
    for (int i = 0; i < 2; ++i) { const float lt = lacc[i][0]; invl[i] = lt > 0.f ? 1.0f / lt : 0.f; }
#pragma unroll
    for (int i = 0; i < 2; ++i) { const size_t tok = (size_t)b * SEQ + qpos;
#pragma unroll
        for (int db = 0; db < 4; ++db) { const f32x4 v = o[i][db] * invl[i]; u32x2 wv; wv.x = cvtpk(v[0], v[1]); wv.y = cvtpk(v[2], v[3]);
            *(u32x2*)(OCMP + tok * 512 + 64 * (hbase + i) + 16 * db + 4 * fq) = wv; } }
    LDS_WAIT();
#pragma unroll
    for (int kt = 0; kt < 4; ++kt)
#pragma unroll
        for (int kb = 0; kb < 4; ++kb) imp[fr * 65 + 16 * kt + 4 * kb + fq] = va[0][kt][kb] * invl[0] + va[1][kt][kb] * invl[1];
    LDS_WAIT();
#pragma unroll
    for (int kt = 0; kt < 4; ++kt)
#pragma unroll
        for (int kb = 0; kb < 4; ++kb) { imp[fr * 65 + 16 * kt + 4 * kb + fq + 1] += vb[0][kt][kb] * invl[0] + vb[1][kt][kb] * invl[1]; LDS_WAIT(); }
    __syncthreads();
    const LAS float* impo = (const LAS float*)(lds + AL_IMP) + (w ^ 1) * (16 * 65);
#pragma unroll 1
    for (int r8 = 0; r8 < 8; ++r8) {
        const int r = 8 * (w & 1) + r8, q = qw0 + r, cur = q >> 6, sblk = lane;
        const float v = imp[r * 65 + lane] + impo[r * 65 + lane];
        const bool future = sblk > cur, forced = (sblk == 0) || (sblk == cur) || (sblk == cur - 1);
        unsigned key = forced ? 0x461C4000u : (__builtin_bit_cast(unsigned, v) & ~63u);
        key = future ? 0u : ((key | (unsigned)(63 - sblk)) + 64u);
        unsigned thr = 0u;
#pragma unroll
        for (int bit = 31; bit >= 0; --bit) { const unsigned cand = thr | (1u << bit); if (__popcll(__ballot(key >= cand)) >= 8) thr = cand; }
        const bool selb = (key >= thr) && (key != 0u);
        const unsigned long long mask = __ballot(selb);
        if (lane == 0) SEL[(size_t)(b * 2 + hkv) * SEQ + q] = mask;
    }
}

__device__ __forceinline__ void attn_phase_main(const Params& p, LAS unsigned char* lds, int l, int G) {
    unsigned char* ws = p.ws; unsigned char* r1 = ws + WS_R1; unsigned char* r2 = ws + WS_R2;
    bf16_t* O = (bf16_t*)(ws + WS_U);
    int tl_ = threadIdx.x; asm volatile("" : "+v"(tl_)); const int lane_ = tl_ & 63;
    const float gAq = wave_max(fabsf(p.a_qk_g[(l * 2 + 0) * 64 + lane_])), gAk = wave_max(fabsf(p.a_qk_g[(l * 2 + 1) * 64 + lane_]));
    const float gCq = wave_max(fabsf(p.c_qk_g[(l * 4 + 0) * 64 + lane_])), gCw = wave_max(fabsf(p.c_qk_g[(l * 4 + 3) * 64 + lane_]));
    const float gBqn = wave_max(fabsf(p.b_qk_nope_g[(l * 2 + 0) * 64 + lane_])), gBkn = wave_max(fabsf(p.b_qk_nope_g[(l * 2 + 1) * 64 + lane_]));
    const float gBqr = wave_max(fabsf(p.b_qk_rope_g[(l * 2 + 0) * 32 + (lane_ & 31)])), gBkr = wave_max(fabsf(p.b_qk_rope_g[(l * 2 + 1) * 32 + (lane_ & 31)]));
    const float gCk = wave_max(fabsf(p.c_qk_g[(l * 4 + 1) * 64 + lane_])); const float shC = uniform_f(1.02f * 8.0f * gCq * gCk * LOG2E);
    const float gCs = wave_max(fabsf(p.c_qk_g[(l * 4 + 2) * 64 + lane_])); const float shS = uniform_f(1.02f * 8.0f * gCq * gCs * LOG2E);
    const float shA = uniform_f(1.02f * 8.0f * gAq * gAk * LOG2E), shW = uniform_f(1.02f * 8.0f * gCq * gCw * LOG2E);
    const float shB = uniform_f(1.02f * sqrtf((64.f * gBqn * gBqn + 32.f * gBqr * gBqr) * (64.f * gBkn * gBkn + 32.f * gBkr * gBkr)) * 0.10206207261596575f * LOG2E);
    volatile LAS float* shl = (volatile LAS float*)(lds + 131072 + 64);
    __syncthreads();
    if (tl_ == 0) { shl[0] = shA; shl[1] = shB; shl[2] = shC; shl[3] = shS; shl[4] = shW; }
    __syncthreads();
    constexpr int NU = 512 + 512 + 1024;
    for (int ui = blockIdx.x; ui < NU; ui += G) {
        if (ui < 512) {
            int qt, bh;
            if (G == 256) { const int xcd = blockIdx.x & 7, loc = blockIdx.x >> 3, hs = loc >> 4, q = loc & 15; if (ui < 256) { bh = xcd + 8 * hs; qt = 15 - q; } else { bh = xcd + 8 * (2 + hs); qt = q; } }
            else { const int j = ui < 256 ? ui : 767 - ui; qt = 15 - (j >> 5); bh = j & 31; }
            AttnPtrs a{(const bf16_t*)(r1 + R1_QB), (const bf16_t*)(r1 + R1_KB), (const bf16_t*)(r1 + R1_VB), O, DM, 256, 0.10206207261596575f * LOG2E, shl[1], nullptr, nullptr, nullptr, nullptr, nullptr, nullptr, 0.f};
            for (int rep = 0; rep < UREP(0); ++rep) attn_flash<1>(lds, a, bh >> 2, bh & 3, qt);
        } else if (ui < 1024) {
            int u = ui - 512;
            if (G == 256) { const int xcd = blockIdx.x & 7, loc = blockIdx.x >> 3, r = u >> 8; u = (xcd + 8 * r) * 32 + loc; }
            AttnPtrs a{(const bf16_t*)(r2 + R2_QA), (const bf16_t*)(r2 + R2_KA), (const bf16_t*)(r2 + R2_VA), O, DM, 0, 0.125f * LOG2E, shl[0], p.a_sinks + l * 4, nullptr, nullptr, nullptr, nullptr, nullptr, 0.f};
            for (int rep = 0; rep < UREP(1); ++rep) attn_flash<0>(lds, a, u >> 6, (u >> 5) & 1, u & 31);
        } else {
            int u = ui - 1024;
            if (G == 256) { const int xcd = blockIdx.x & 7, loc = blockIdx.x >> 3, r = u >> 8;
                u = (xcd + 8 * (r >> 1)) * 64 + ((r & 1) ? loc : 63 - loc); }
            for (int rep = 0; rep < UREP(3); ++rep) {
                attn_cmp(lds, (const bf16_t*)(r2 + R2_QC), (const bf16_t*)(r2 + R2_KCMP), (const bf16_t*)(r2 + R2_VCMP), (bf16_t*)(r1 + R1_OCMP), (unsigned long long*)(r2 + R2_SEL), shl[2], u >> 7, (u >> 6) & 1, u & 63);
                asm volatile("s_waitcnt vmcnt(0)" ::: "memory");
                __syncthreads();
                AttnPtrs a{(const bf16_t*)(r2 + R2_QCR), (const bf16_t*)(r2 + R2_KS), (const bf16_t*)(r2 + R2_VS), O, DM, 512, 0.125f * LOG2E, shl[3], nullptr,
                           (const unsigned long long*)(r2 + R2_SEL), (const float*)(r2 + R2_GATES), (const bf16_t*)(r1 + R1_OCMP), (const bf16_t*)(r2 + R2_KW), (const bf16_t*)(r2 + R2_VW), shl[4]};
                attn_flash<3>(lds, a, u >> 7, (u >> 6) & 1, u & 63);
            }
        }
    }
    __syncthreads();
}
__device__ __forceinline__ void attn_phase_slc(const Params& p, LAS unsigned char* lds, int l, int G) {
    unsigned char* ws = p.ws; unsigned char* r1 = ws + WS_R1; unsigned char* r2 = ws + WS_R2;
    int tl_ = threadIdx.x; asm volatile("" : "+v"(tl_)); const int lane_ = tl_ & 63;
    const float gCq = wave_max(fabsf(p.c_qk_g[(l * 4 + 0) * 64 + lane_])), gCs = wave_max(fabsf(p.c_qk_g[(l * 4 + 2) * 64 + lane_]));
    const float shS = uniform_f(1.02f * 8.0f * gCq * gCs * LOG2E);
    const float gCw2 = wave_max(fabsf(p.c_qk_g[(l * 4 + 3) * 64 + lane_])); const float shW2 = uniform_f(1.02f * 8.0f * gCq * gCw2 * LOG2E);
    for (int u0 = blockIdx.x; u0 < 1024; u0 += G) {
        int u = u0;
        if (G == 256) { const int xcd = blockIdx.x & 7, loc = blockIdx.x >> 3, r = u0 >> 8;
            u = (xcd + 8 * (r >> 1)) * 64 + ((r & 1) ? loc : 63 - loc); }
        AttnPtrs a{(const bf16_t*)(r2 + R2_QCR), (const bf16_t*)(r2 + R2_KS), (const bf16_t*)(r2 + R2_VS), (bf16_t*)(ws + WS_U), DM, 512, 0.125f * LOG2E, shS, nullptr,
                   (const unsigned long long*)(r2 + R2_SEL), (const float*)(r2 + R2_GATES), (const bf16_t*)(r1 + R1_OCMP), (const bf16_t*)(r2 + R2_KW), (const bf16_t*)(r2 + R2_VW), shW2};
        attn_flash<3>(lds, a, u >> 7, (u >> 6) & 1, u & 63);
    }
    __syncthreads();
}

__global__ void __launch_bounds__(NTHREADS, 2) fwd_megakernel(Params p) {
    extern __shared__ __attribute__((aligned(16))) unsigned char smem[];
    LAS unsigned char* lds = (LAS unsigned char*)smem;
    cg::grid_group grid = cg::this_grid();
    const int G = gridDim.x, ngw = G * NWAVES;
    volatile LAS unsigned* bst = (volatile LAS unsigned*)(lds + 131072);
    if (threadIdx.x < 2) bst[threadIdx.x] = 0u;
    __syncthreads();
    (void)xcd_barrier_post((unsigned*)(p.ws + WS_BAR), bst);
    for (int ph = p.ph_lo; ph < p.ph_hi; ++ph) {
        bool nosync = false;
#define MKLANE int tid_ = threadIdx.x; asm volatile("" : "+v"(tid_)); const int tid = tid_, lane = tid & 63, wave = __builtin_amdgcn_readfirstlane(tid >> 6), gw = blockIdx.x * NWAVES + wave; (void)tid; (void)lane; (void)wave; (void)gw;
        unsigned char* ws = p.ws; asm volatile("" : "+s"(ws));
        if (ph == 0) { MKLANE if (PHON(0)) for (int rep = 0; rep < NREP(0); ++rep) { prologue(p, lds, tid, wave, lane, G); __syncthreads(); } }
        else {
            const int l = (ph - 1) / 16, k = (ph - 1) % 16;
            const float* modl = (const float*)(ws + WS_MOD) + (size_t)l * NBATCH * NMOD * DM;
            if (PHON(1) && (k == 0 || k == 3 || k == 13) && !(FUSE_NORM && G == 256 && !(l == 0 && k == 0))) {
                MKLANE
                const int j = k == 0 ? 0 : (k == 3 ? 1 : 2);
                const float* hin = (l == 0 && k == 0) ? p.x : p.out;
                if (l == 0 && k == 0 && blockIdx.x == 0) {
                    const float* CMPBP = (const float*)(ws + WS_CMPBP); float* CMPB = (float*)(ws + WS_CMPB);
                    for (int i = tid; i < 8 * 128; i += NTHREADS) { const int m = i >> 7, n = i & 127; float a = 0.f;
                        for (int sl = 0; sl < 32; ++sl) a += CMPBP[((size_t)m * 32 + sl) * 128 + n];
                        CMPB[i] = a; }
                }
                for (int rep = 0; rep < NREP(1); ++rep) norm_phase(hin, (bf16_t*)(ws + WS_U), p.norm_g + (size_t)(l * 3 + j) * DM, modl, 3 * j + 1, 3 * j, gw, ngw, lane);
            } else if (PHON(2) && (k == 1 || k == 14)) {
                const int f = k == 1 ? 0 : 1;
                pg8::Gemm g{(const bf16_t*)(ws + WS_U), (const bf16_t*)(ws + WS_W1T) + (size_t)(l * 2 + f) * 2 * DFF * DM, DM, DM, T, 2 * DFF, DM};
                pg8::StaticOrder S; S.init(g.M, g.N, G, blockIdx.x);
                pg8::EpiSwiglu E{(bf16_t*)(ws + WS_R1)};
                for (int rep = 0; rep < NREP(2); ++rep) pg8::gemm_phase(lds, g, S, E);
            } else if (PHON(3) && (k == 2 || k == 12 || k == 15)) {
                pg8::Gemm g;
                if (k == 12) g = pg8::Gemm{(const bf16_t*)(ws + WS_U), (const bf16_t*)(ws + WS_WOUTT) + (size_t)l * DM * DM, DM, DM, T, DM, DM};
                else g = pg8::Gemm{(const bf16_t*)(ws + WS_R1), (const bf16_t*)(ws + WS_W2T) + (size_t)(l * 2 + (k == 2 ? 0 : 1)) * DM * DFF, DFF, DFF, T, DM, DFF};
                pg8::StaticOrder S; S.init(g.M, g.N, G, blockIdx.x);
                const int gi = k == 2 ? 2 : (k == 12 ? 5 : 8);
                for (int rep = 0; rep < NREP(3); ++rep) {
                    const bool fuse = FUSE_NORM && G == 256 && !(k == 15 && l == DEPTH - 1) && (rep + 1 == NREP(3));
                    const int ln = k == 15 ? l + 1 : l, jn = k == 2 ? 1 : (k == 12 ? 2 : 0), call = l * 3 + (k == 2 ? 0 : (k == 12 ? 1 : 2));
                    const float* modn = (const float*)(ws + WS_MOD) + (size_t)ln * NBATCH * NMOD * DM;
                    pg8::EpiResid E{(l == 0 && k == 2) ? p.x : p.out, p.out, modl + gi * DM, (rep + 1 < NREP(3)) ? 0.0f : (k == 12 ? 1.0f : 0.5f),
                                    fuse ? p.norm_g + (size_t)(ln * 3 + jn) * DM : nullptr, modn + (3 * jn + 1) * DM, modn + (3 * jn) * DM, (bf16_t*)(ws + WS_U), (float*)(ws + WS_XBUF),
                                    (unsigned*)(ws + WS_BAR + 16384) + call * 128, lds + 131072 + 256};
                    pg8::gemm_phase(lds, g, S, E);
                }
            } else if (PHON(4) && k == 4) {
                pg8::Gemm g{(const bf16_t*)(ws + WS_U), (const bf16_t*)(ws + WS_WINT) + (size_t)l * DINP * DM, DM, DM, T, DINP, DM};
                unsigned char* r2 = ws + WS_R2;
                pg8::EpiMixIn E{(bf16_t*)(r2 + R2_QA), (bf16_t*)(r2 + R2_KA), (bf16_t*)(r2 + R2_VA), (bf16_t*)(r2 + R2_QC), (bf16_t*)(r2 + R2_QCR), (bf16_t*)(r2 + R2_ZK), (bf16_t*)(r2 + R2_ZV),
                                (bf16_t*)(r2 + R2_KS), (bf16_t*)(r2 + R2_VS), (bf16_t*)(r2 + R2_KW), (bf16_t*)(r2 + R2_VW), (bf16_t*)(ws + WS_R1),
                                p.a_qk_g + (l * 2 + 0) * 64, p.a_qk_g + (l * 2 + 1) * 64, p.c_qk_g + (l * 4 + 0) * 64, p.c_qk_g + (l * 4 + 2) * 64, p.c_qk_g + (l * 4 + 3) * 64,
                                (const float*)(ws + WS_COS64), (const float*)(ws + WS_SIN64)};
                pg8::StaticOrder S; S.init(g.M, g.N, G, blockIdx.x);
                for (int rep = 0; rep < NREP(4); ++rep) pg8::gemm_phase(lds, g, S, E);
            } else if (PHON(4) && (k == 6 || k == 7)) {
                pg8::Gemm g;
                if (k == 6) g = pg8::Gemm{(const bf16_t*)(ws + WS_R2 + R2_CQN), (const bf16_t*)(ws + WS_WUQT) + (size_t)l * 512 * 256, 256, 256, T, 512, 256};
                else g = pg8::Gemm{(const bf16_t*)(ws + WS_R2 + R2_CKVN), (const bf16_t*)(ws + WS_WUKVT) + (size_t)l * 512 * 128, 128, 128, T, 512, 128};
                pg8::EpiMixB E{k == 6, (bf16_t*)(ws + WS_R1 + R1_QB), (bf16_t*)(ws + WS_R1 + R1_KB), (bf16_t*)(ws + WS_R1 + R1_VB), (const bf16_t*)(ws + WS_R2 + R2_KPE),
                               p.b_qk_nope_g + (l * 2 + 0) * 64, p.b_qk_rope_g + (l * 2 + 0) * 32, p.b_qk_nope_g + (l * 2 + 1) * 64, (const float*)(ws + WS_COS32), (const float*)(ws + WS_SIN32)};
                pg8::StaticOrder S; S.init(g.M, g.N, G, blockIdx.x);
                for (int rep = 0; rep < NREP(4); ++rep) pg8::gemm_phase(lds, g, S, E);
                if (k == 7 && PHON(6)) { MKLANE for (int rep = 0; rep < NREP(6); ++rep) postproc_b(p, lds, l, gw, ngw, lane); }
            } else if (PHON(5) && k == 5) {
                { MKLANE
                  for (int rep = 0; rep < NREP(5); ++rep) postproc_a2(p, lds, l, gw, ngw, lane); }
                __syncthreads();
                pg8::Gemm g{(const bf16_t*)(ws + WS_R2 + R2_ZK), (const bf16_t*)(ws + WS_WC1T) + (size_t)l * 256 * 2048, 1024, 2048, 8192, 256, 512, 1024};
                pg8::StaticOrder S; S.init(g.M, 4 * 256, G, blockIdx.x);
                pg8::EpiCmp E{(float*)(ws + WS_R1 + R1_HIDP)};
                for (int rep = 0; rep < NREP(9); ++rep) pg8::gemm_phase(lds, g, S, E);
            } else if (PHON(7) && k == 10) {
                for (int rep = 0; rep < NREP(7); ++rep) attn_phase_main(p, lds, l, G);
            }
            nosync = (k == 6 || k == 8 || k == 9 || k == 11) || (FUSE_NORM && G == 256 && (k == 0 || k == 3 || k == 13) && !(l == 0 && k == 0));
        }
        if (ph + 1 < p.ph_hi && !nosync) for (int rep = 0; rep < NREP(10); ++rep) {
            if (ph == 0) grid.sync();
            else { XcdBarrier xb_; xb_.bar = (unsigned*)(p.ws + WS_BAR); xb_.x = xb_xcc_id(); xb_.st = (volatile LAS unsigned*)(lds + 131072); xcd_barrier(xb_); }
        }
    }
}

constexpr int LDS_BYTES = 144 * 1024;
constexpr int NPHASES = 1 + 16 * DEPTH;
extern "C" void kernel_launch(void* const* d_in, const int* in_sizes, int n_in, void* d_out, int out_size, void* d_ws, size_t ws_size, hipStream_t stream) {
    static int grid = 0;
    if (grid == 0) {
        if (n_in != 24 || out_size != T * DM || ws_size < WS_END) { fprintf(stderr, "kernel_launch: unexpected problem (n_in %d, out %d, ws %zu; need ws >= %zu)\n", n_in, out_size, ws_size, (size_t)WS_END); grid = -1; return; }
        int dev = 0, cus = 0, per_cu = 0;
        hipGetDevice(&dev);
        hipDeviceGetAttribute(&cus, hipDeviceAttributeMultiprocessorCount, dev);
        if (hipFuncSetAttribute((const void*)fwd_megakernel, hipFuncAttributeMaxDynamicSharedMemorySize, LDS_BYTES) != hipSuccess) { fprintf(stderr, "kernel_launch: hipFuncSetAttribute failed\n"); grid = -1; return; }
        if (hipOccupancyMaxActiveBlocksPerMultiprocessor(&per_cu, (const void*)fwd_megakernel, NTHREADS, LDS_BYTES) != hipSuccess || per_cu < 1) { fprintf(stderr, "kernel_launch: occupancy query says %d\n", per_cu); per_cu = 1; }
        (void)hipGetLastError();
        grid = cus * 1;
        fprintf(stderr, "kernel_launch: grid %d (occupancy %d/CU)\n", grid, per_cu);
    }
    if (grid < 0) return;
    Params p{};
    const float** fp = (const float**)&p;
    for (int i = 0; i < 24; ++i) fp[i] = (const float*)d_in[i];
    p.out = (float*)d_out; p.ws = (unsigned char*)d_ws;
#if MK_ONE_LAUNCH
    if (hipMemsetAsync((unsigned char*)d_ws + WS_BAR, 0, BAR_BYTES, stream) != hipSuccess) { fprintf(stderr, "kernel_launch: memset failed\n"); return; }
    p.ph_lo = 0; p.ph_hi = NPHASES;
    void* args[] = {&p};
    hipError_t e = hipLaunchCooperativeKernel((const void*)fwd_megakernel, dim3(grid), dim3(NTHREADS), args, LDS_BYTES, stream);
    if (e != hipSuccess) fprintf(stderr, "kernel_launch: cooperative launch failed: %s (grid %d)\n", hipGetErrorString(e), grid);
#else
    for (int ph = 0; ph < NPHASES; ++ph) { p.ph_lo = ph; p.ph_hi = ph + 1; hipLaunchKernelGGL(fwd_megakernel, dim3(grid), dim3(NTHREADS), LDS_BYTES, stream, p); }
#endif
}
```

```cpp
#include <hip/hip_runtime.h>
#include <hip/hip_cooperative_groups.h>
#include <cstdio>
#include <cstdint>
namespace cg = cooperative_groups;

#define LAS __attribute__((address_space(3)))
typedef unsigned short bf16_t;
typedef short bf16x8 __attribute__((ext_vector_type(8)));
typedef short bf16x4 __attribute__((ext_vector_type(4)));
typedef float f32x4 __attribute__((ext_vector_type(4)));
typedef float f32x2 __attribute__((ext_vector_type(2)));
typedef unsigned u32x4 __attribute__((ext_vector_type(4)));
typedef unsigned u32x2 __attribute__((ext_vector_type(2)));
typedef __bf16 bf16x2_t __attribute__((ext_vector_type(2)));

#ifndef PHM
#define PHM 0xffff
#endif
#define PHON(n) (((PHM) >> (n)) & 1)
#ifndef DUPM
#define DUPM 0
#endif
#define NREP(n) (1 + (((DUPM) >> (n)) & 1))
#ifndef DUPU
#define DUPU 0
#endif
#define UREP(n) (1 + (((DUPU) >> (n)) & 1))
#ifndef FUSE_NORM
#define FUSE_NORM 1
#endif
#ifndef MK_ONE_LAUNCH
#define MK_ONE_LAUNCH 1
#endif

constexpr int DM = 1024, NBATCH = 8, SEQ = 4096, T = NBATCH * SEQ, DEPTH = 4, DFF = 2816, NMOD = 9;
constexpr int DIN = 2272, DINP = 2304;
constexpr float EPS = 1e-6f, LOG2E = 1.4426950408889634f;
constexpr int NTHREADS = 512, NWAVES = 8;

constexpr size_t MiB = 1u << 20;
constexpr size_t WS_MOD = 0;
constexpr size_t WS_CMPB = 2 * MiB;
constexpr size_t WS_CMPBP = 2 * MiB + 65536;
constexpr size_t WS_BAR = 2 * MiB + 524288, BAR_BYTES = 16384 + 8192;
constexpr size_t WS_XBUF = 15 * MiB;
constexpr size_t WS_COS64 = 3 * MiB, WS_SIN64 = 7 * MiB, WS_COS32 = 11 * MiB, WS_SIN32 = 13 * MiB;
constexpr size_t WS_W1T = 16 * MiB;
constexpr size_t WS_W2T = 104 * MiB;
constexpr size_t WS_WINT = 148 * MiB;
constexpr size_t WS_WOUTT = 166 * MiB;
constexpr size_t WS_WUQT = 174 * MiB;
constexpr size_t WS_WUKVT = 175 * MiB;
constexpr size_t WS_WC1T = 176 * MiB;
constexpr size_t WS_U = 180 * MiB;
constexpr size_t WS_R1 = 244 * MiB;
constexpr size_t WS_R2 = 420 * MiB;
constexpr size_t WS_END = 596 * MiB;
constexpr size_t R1_HIDP = 130 * MiB;
constexpr size_t R1_QBR = 0, R1_KVBR = 32 * MiB, R1_HID = 64 * MiB, R1_QB = 66 * MiB, R1_KB = 90 * MiB, R1_VB = 114 * MiB, R1_OWIN = 0, R1_OCMP = 32 * MiB;
constexpr size_t R2_QA = 0, R2_KA = 16 * MiB, R2_VA = 24 * MiB, R2_CQN = 32 * MiB, R2_CKVN = 48 * MiB, R2_KPE = 56 * MiB, R2_QC = 58 * MiB, R2_QCR = 90 * MiB,
                 R2_ZK = 122 * MiB, R2_ZV = 130 * MiB, R2_KS = 139 * MiB, R2_VS = 147 * MiB, R2_KW = 155 * MiB, R2_VW = 163 * MiB, R2_GATES = 171 * MiB,
                 R2_KCMP = 174 * MiB, R2_VCMP = 174 * MiB + 512 * 1024, R2_SEL = 175 * MiB;

__device__ __forceinline__ unsigned cvtpk(float lo, float hi) { f32x2 v = {lo, hi}; bf16x2_t b = __builtin_convertvector(v, bf16x2_t); return __builtin_bit_cast(unsigned, b); }
__device__ __forceinline__ unsigned f2bf(float f) { unsigned u = __builtin_bit_cast(unsigned, f); return (u + 0x7fffu + ((u >> 16) & 1u)) >> 16; }
__device__ __forceinline__ unsigned pk2(float lo, float hi) { return f2bf(lo) | (f2bf(hi) << 16); }
__device__ __forceinline__ float bf2f(unsigned h) { return __builtin_bit_cast(float, h << 16); }
__device__ __forceinline__ float wave_sum(float v) {
#pragma unroll
    for (int o = 1; o < 64; o <<= 1) v += __shfl_xor(v, o);
    return v;
}
__device__ __forceinline__ float wave_max(float v) {
#pragma unroll
    for (int o = 1; o < 64; o <<= 1) v = fmaxf(v, __shfl_xor(v, o));
    return v;
}
__device__ __forceinline__ float uniform_f(float v) { return __builtin_bit_cast(float, __builtin_amdgcn_readfirstlane(__builtin_bit_cast(int, v))); }
__device__ __forceinline__ float fast_exp2(float x) { return __builtin_amdgcn_exp2f(x); }
__device__ __forceinline__ float silu_f(float g) { return g * __builtin_amdgcn_rcpf(1.0f + fast_exp2(-g * LOG2E)); }
#define LDS_WAIT() asm volatile("s_waitcnt lgkmcnt(0)" ::: "memory")

namespace pg8 {
constexpr int BM = 256, BK = 64, HALF = 128, HTB = HALF * BK * 2, STAGE_BYTES = 8 * HTB, NXCD = 8, WGM = 8;
__host__ __device__ __forceinline__ int lds_byte(int r, int c) { const int st = (r >> 4) * 2 + (c >> 5), rr = r & 15, cc = c & 31, ob = rr * 64 + cc * 2; return st * 1024 + (ob ^ (((ob >> 9) & 1) << 5)); }
__host__ __device__ __forceinline__ void stage_rc(int b, int& R, int& C) { const int st = b / 1024, sb = b % 1024, swz = sb ^ (((sb >> 9) & 1) << 5); R = (st >> 1) * 16 + swz / 64; C = (st & 1) * 32 + (swz % 64) / 2; }
__host__ __device__ __forceinline__ int perm32(int rho) { const int n = rho >> 4, i = rho & 15; return 8 * (i >> 2) + 4 * n + (i & 3); }

struct Unit { int pm, pn; };
struct Gemm { const bf16_t* A; const bf16_t* Bt; int lda, ldb, M, N, K; int ksb = 0; };

struct StaticOrder {
    int nM, nN, nwg, G, c;
    __device__ void init(int M, int N, int G_, int c_) { nM = M / BM; nN = N / BM; nwg = nM * nN; G = G_; c = c_; }
    __device__ bool next(int i, Unit& u) const {
        const long L = (long)i * G + c; if (L >= nwg) return false;
        int wgid = (int)L; { const int q = nwg / NXCD, r = nwg % NXCD, xcd = wgid % NXCD, off = wgid / NXCD; wgid = (xcd < r ? xcd * (q + 1) : r * (q + 1) + (xcd - r) * q) + off; }
        const int nig = WGM * nN, gid = wgid / nig, fm = gid * WGM, gsz = (nM - fm) < WGM ? (nM - fm) : WGM;
        u.pm = fm + ((wgid % nig) % gsz); u.pn = (wgid % nig) / gsz; return true;
    }
};

struct EpiMixIn {
    static constexpr bool PERM = true;
    bf16_t *QA, *KA, *VA, *QC, *QCR, *ZK, *ZV, *KS, *VS, *KW, *VW, *P2;
    const float *gaq, *gak, *gcq, *gcs, *gcw, *C64, *S64;
    __device__ __forceinline__ void operator()(const f32x4 (&acc)[2][2][4][2], const Unit& u, int wr, int wc, int fr, int fq) const {
        const int pn = u.pn, row0 = u.pm * BM + wr * 64 + fr;
        if (pn >= 7) {
            const int col0 = (pn - 7) * BM + wc * 32 + 8 * fq;
#pragma unroll
            for (int ai = 0; ai < 2; ++ai)
#pragma unroll
                for (int m = 0; m < 4; ++m) { bf16_t* rowp = P2 + (size_t)(row0 + ai * HALF + m * 16) * 512 + col0;
#pragma unroll
                    for (int bj = 0; bj < 2; ++bj) { const f32x4 v0 = acc[ai][bj][m][0], v1 = acc[ai][bj][m][1];
                        u32x4 w; w.x = cvtpk(v0[0], v0[1]); w.y = cvtpk(v0[2], v0[3]); w.z = cvtpk(v1[0], v1[1]); w.w = cvtpk(v1[2], v1[3]);
                        *(u32x4*)(rowp + bj * HALF) = w; } }
            return;
        }
        bf16_t* dst; const float* gp = nullptr; int Hn, h; bool rope = false; float scale = 1.0f; bool two = false;
        const bool lo = wc < 2; const int h2 = wc & 1;
        if (pn == 0) { dst = QA; Hn = 4; h = wc; gp = gaq; rope = true; scale = 0.125f * LOG2E; }
        else if (pn == 1) { Hn = 2; h = h2; if (lo) { dst = KA; gp = gak; rope = true; } else dst = VA; }
        else if (pn <= 3) { dst = QCR; Hn = 8; h = 4 * (pn - 2) + wc; gp = gcq; rope = true; scale = 0.125f * LOG2E; two = true; }
        else if (pn == 4) { Hn = 2; h = h2; dst = lo ? ZK : ZV; }
        else if (pn == 5) { Hn = 2; h = h2; if (lo) { dst = KS; gp = gcs; rope = true; } else dst = VS; }
        else { Hn = 2; h = h2; if (lo) { dst = KW; gp = gcw; rope = true; } else dst = VW; }
        f32x4 ga[2], gb[2];
#pragma unroll
        for (int n = 0; n < 2; ++n) { ga[n] = gp ? *(const f32x4*)(gp + 8 * fq + 4 * n) : (f32x4){1.f, 1.f, 1.f, 1.f}; gb[n] = gp ? *(const f32x4*)(gp + 32 + 8 * fq + 4 * n) : (f32x4){1.f, 1.f, 1.f, 1.f}; }
        const int b = u.pm >> 4;
#pragma unroll
        for (int ai = 0; ai < 2; ++ai)
#pragma unroll
            for (int m = 0; m < 4; ++m) {
                const int row = row0 + ai * HALF + m * 16, s_ = row & 4095;
                f32x4 a[2], bb[2];
#pragma unroll
                for (int n = 0; n < 2; ++n) { a[n] = acc[ai][0][m][n]; bb[n] = acc[ai][1][m][n]; }
                float r = scale;
                if (gp) { float ss = 0.f;
#pragma unroll
                    for (int n = 0; n < 2; ++n)
#pragma unroll
                        for (int e = 0; e < 4; ++e) ss += a[n][e] * a[n][e] + bb[n][e] * bb[n][e];
                    ss += __shfl_xor(ss, 16); ss += __shfl_xor(ss, 32);
                    r = rsqrtf(ss * (1.0f / 64) + EPS) * scale; }
#pragma unroll
                for (int n = 0; n < 2; ++n) { a[n] = a[n] * r * ga[n]; bb[n] = bb[n] * r * gb[n]; }
                const size_t o = ((size_t)(b * Hn + h) * SEQ + s_) * 64 + 8 * fq;
                if (two) { u32x4 w; w.x = cvtpk(a[0][0], a[0][1]); w.y = cvtpk(a[0][2], a[0][3]); w.z = cvtpk(a[1][0], a[1][1]); w.w = cvtpk(a[1][2], a[1][3]); *(u32x4*)(QC + o) = w;
                    w.x = cvtpk(bb[0][0], bb[0][1]); w.y = cvtpk(bb[0][2], bb[0][3]); w.z = cvtpk(bb[1][0], bb[1][1]); w.w = cvtpk(bb[1][2], bb[1][3]); *(u32x4*)(QC + o + 32) = w; }
                if (rope) {
#pragma unroll
                    for (int n = 0; n < 2; ++n) { const f32x4 cs = *(const f32x4*)(C64 + (size_t)row * 32 + 8 * fq + 4 * n), sn = *(const f32x4*)(S64 + (size_t)row * 32 + 8 * fq + 4 * n);
                        const f32x4 ya = a[n], yb = bb[n]; a[n] = ya * cs - yb * sn; bb[n] = yb * cs + ya * sn; } }
                u32x4 w; w.x = cvtpk(a[0][0], a[0][1]); w.y = cvtpk(a[0][2], a[0][3]); w.z = cvtpk(a[1][0], a[1][1]); w.w = cvtpk(a[1][2], a[1][3]); *(u32x4*)(dst + o) = w;
                w.x = cvtpk(bb[0][0], bb[0][1]); w.y = cvtpk(bb[0][2], bb[0][3]); w.z = cvtpk(bb[1][0], bb[1][1]); w.w = cvtpk(bb[1][2], bb[1][3]); *(u32x4*)(dst + o + 32) = w;
            }
    }
};
struct EpiMixB {
    static constexpr bool PERM = true;
    bool isq; bf16_t *QB, *KB, *VB; const bf16_t* KPE; const float *gqn, *gqr, *gkn, *C32, *S32;
    __device__ __forceinline__ void operator()(const f32x4 (&acc)[2][2][4][2], const Unit& u, int wr, int wc, int fr, int fq) const {
        const int pn = u.pn, row0 = u.pm * BM + wr * 64 + fr, b = u.pm >> 4;
        const float SC = 0.10206207261596575f * LOG2E;
        const bool rope = isq && pn == 1, isv = !isq && (wc & 1);
        const int h = isq ? wc : 2 * pn + (wc >> 1);
        const float* gp = isq ? (rope ? gqr : gqn) : (isv ? nullptr : gkn);
        const int hstep = rope ? 16 : 32;
        f32x4 ga[2], gb[2];
#pragma unroll
        for (int n = 0; n < 2; ++n) { const bool ok = gp && (!rope || fq < 2);
            ga[n] = ok ? *(const f32x4*)(gp + 8 * fq + 4 * n) : (f32x4){1.f, 1.f, 1.f, 1.f}; gb[n] = ok ? *(const f32x4*)(gp + hstep + 8 * fq + 4 * n) : (f32x4){1.f, 1.f, 1.f, 1.f}; }
#pragma unroll
        for (int ai = 0; ai < 2; ++ai)
#pragma unroll
            for (int m = 0; m < 4; ++m) {
                const int row = row0 + ai * HALF + m * 16, s_ = row & 4095;
                f32x4 a[2], bb[2];
#pragma unroll
                for (int n = 0; n < 2; ++n) { a[n] = acc[ai][0][m][n]; bb[n] = acc[ai][1][m][n]; }
                float r = 1.0f;
                if (gp) { float ss = 0.f;
#pragma unroll
                    for (int n = 0; n < 2; ++n)
#pragma unroll
                        for (int e = 0; e < 4; ++e) ss += a[n][e] * a[n][e] + bb[n][e] * bb[n][e];
                    ss += __shfl_xor(ss, 16); ss += __shfl_xor(ss, 32);
                    r = rsqrtf(ss * (rope ? 1.0f / 32 : 1.0f / 64) + EPS) * (isq ? SC : 1.0f); }
#pragma unroll
                for (int n = 0; n < 2; ++n) { a[n] = a[n] * r * ga[n]; bb[n] = bb[n] * r * gb[n]; }
                if (rope && fq < 2) {
#pragma unroll
                    for (int n = 0; n < 2; ++n) { const f32x4 cs = *(const f32x4*)(C32 + (size_t)row * 16 + 8 * fq + 4 * n), sn = *(const f32x4*)(S32 + (size_t)row * 16 + 8 * fq + 4 * n);
                        const f32x4 ya = a[n], yb = bb[n]; a[n] = ya * cs - yb * sn; bb[n] = yb * cs + ya * sn; } }
                u32x4 wa, wb; wa.x = cvtpk(a[0][0], a[0][1]); wa.y = cvtpk(a[0][2], a[0][3]); wa.z = cvtpk(a[1][0], a[1][1]); wa.w = cvtpk(a[1][2], a[1][3]);
                wb.x = cvtpk(bb[0][0], bb[0][1]); wb.y = cvtpk(bb[0][2], bb[0][3]); wb.z = cvtpk(bb[1][0], bb[1][1]); wb.w = cvtpk(bb[1][2], bb[1][3]);
                const size_t hs = (size_t)(b * 4 + h) * SEQ + s_;
                if (isq) { bf16_t* d = QB + hs * 96;
                    if (!rope) { *(u32x4*)(d + 8 * fq) = wa; *(u32x4*)(d + 32 + 8 * fq) = wb; }
                    else if (fq < 2) { *(u32x4*)(d + 64 + 8 * fq) = wa; *(u32x4*)(d + 80 + 8 * fq) = wb; } }
                else if (!isv) { bf16_t* d = KB + hs * 96; *(u32x4*)(d + 8 * fq) = wa; *(u32x4*)(d + 32 + 8 * fq) = wb;
                    *(u32x4*)(d + 64 + 8 * fq) = *(const u32x4*)(KPE + (size_t)row * 32 + 8 * fq); }
                else { bf16_t* d = VB + hs * 64; *(u32x4*)(d + 8 * fq) = wa; *(u32x4*)(d + 32 + 8 * fq) = wb; }
            }
    }
};
struct EpiSwiglu {
    static constexpr bool PERM = true;
    bf16_t* O;
    __device__ __forceinline__ void operator()(const f32x4 (&acc)[2][2][4][2], const Unit& u, int wr, int wc, int fr, int fq) const {
        const int row0 = u.pm * BM + wr * 64 + fr, col0 = u.pn * HALF + wc * 32 + 8 * fq;
#pragma unroll
        for (int ai = 0; ai < 2; ++ai)
#pragma unroll
            for (int m = 0; m < 4; ++m) { bf16_t* rowp = O + (size_t)(row0 + ai * HALF + m * 16) * DFF + col0;
                float r[8];
#pragma unroll
                for (int n = 0; n < 2; ++n)
#pragma unroll
                    for (int e = 0; e < 4; ++e) r[n * 4 + e] = silu_f(acc[ai][0][m][n][e]) * acc[ai][1][m][n][e];
                u32x4 w; w.x = cvtpk(r[0], r[1]); w.y = cvtpk(r[2], r[3]); w.z = cvtpk(r[4], r[5]); w.w = cvtpk(r[6], r[7]);
                *(u32x4*)rowp = w; }
    }
};
struct EpiResid {
    static constexpr bool PERM = true;
    const float* base; float* out; const float* gate; float coef;
    const float* nxg; const float* nxsc; const float* nxsh; bf16_t* U; float* xbuf; unsigned* cnt; LAS unsigned char* xl;
    __device__ __forceinline__ void operator()(f32x4 (&acc)[2][2][4][2], const Unit& u, int wr, int wc, int fr, int fq) const {
        const float coef_ = uniform_f(coef);
        const unsigned long long nxa = (unsigned long long)(uintptr_t)this->nxg;
        const float* nxg = (const float*)(uintptr_t)(((unsigned long long)(unsigned)__builtin_amdgcn_readfirstlane((int)(nxa >> 32)) << 32) | (unsigned)__builtin_amdgcn_readfirstlane((int)nxa));
        const int b = u.pm >> 4; const float* gv = gate + (size_t)b * (NMOD * DM);
        const int col0 = u.pn * BM + wc * 32 + 8 * fq;
        f32x4 g4[2][2];
#pragma unroll
        for (int bj = 0; bj < 2; ++bj)
#pragma unroll
            for (int n = 0; n < 2; ++n) g4[bj][n] = *(const f32x4*)(gv + col0 + bj * HALF + n * 4) * coef_;
#pragma unroll
        for (int ai = 0; ai < 2; ++ai)
#pragma unroll
            for (int m = 0; m < 4; ++m) { const size_t off = (size_t)(u.pm * BM + wr * 64 + fr + ai * HALF + m * 16) * DM + col0;
#pragma unroll
                for (int bj = 0; bj < 2; ++bj)
#pragma unroll
                    for (int n = 0; n < 2; ++n) { const f32x4 bs = *(const f32x4*)(base + off + bj * HALF + n * 4);
                        const f32x4 v = bs + g4[bj][n] * acc[ai][bj][m][n]; *(f32x4*)(out + off + bj * HALF + n * 4) = v; acc[ai][bj][m][n] = v; } }
        if (!nxg) return;
        LAS float* P = (LAS float*)xl; LAS float* S = (LAS float*)(xl + 4096); LAS unsigned* flag = (LAS unsigned*)(xl + 5120);
        const int tid = threadIdx.x, wid = tid >> 6, lane = tid & 63;
#pragma unroll
        for (int ai = 0; ai < 2; ++ai)
#pragma unroll
            for (int m = 0; m < 4; ++m) { float ss = 0.f;
#pragma unroll
                for (int bj = 0; bj < 2; ++bj)
#pragma unroll
                    for (int n = 0; n < 2; ++n) { const f32x4 v = acc[ai][bj][m][n]; ss += (v[0] * v[0] + v[1] * v[1]) + (v[2] * v[2] + v[3] * v[3]); }
                ss += __shfl_xor(ss, 16); ss += __shfl_xor(ss, 32);
                if (fq == 0) P[(ai * HALF + wr * 64 + m * 16 + fr) * 4 + wc] = ss; }
        asm volatile("s_waitcnt lgkmcnt(0)" ::: "memory"); __builtin_amdgcn_s_barrier(); asm volatile("" ::: "memory");
        if (tid < 256) { const float t = (P[tid * 4 + 0] + P[tid * 4 + 1]) + (P[tid * 4 + 2] + P[tid * 4 + 3]);
            __hip_atomic_store(xbuf + ((size_t)(u.pm * BM + tid) * 4 + u.pn), t, __ATOMIC_RELAXED, __HIP_MEMORY_SCOPE_AGENT); }
        asm volatile("s_waitcnt vmcnt(0)" ::: "memory");
        if (tid < 256 && lane == 0) __hip_atomic_fetch_add(cnt + u.pm, 1u, __ATOMIC_RELAXED, __HIP_MEMORY_SCOPE_AGENT);
        if (wid == 0) { unsigned spins = 0; bool dead = false;
            while ((unsigned)__builtin_amdgcn_readfirstlane((int)__hip_atomic_load(cnt + u.pm, __ATOMIC_RELAXED, __HIP_MEMORY_SCOPE_AGENT)) < 16u) { __builtin_amdgcn_s_sleep(2); if (++spins > (1u << 20)) { dead = true; break; } }
            __builtin_amdgcn_fence(__ATOMIC_ACQUIRE, "agent");
            if (lane == 0) flag[0] = dead ? 1u : 0u; }
        asm volatile("s_waitcnt vmcnt(0) lgkmcnt(0)" ::: "memory"); __builtin_amdgcn_s_barrier(); asm volatile("" ::: "memory");
        if (tid < 256) { const float* sl = xbuf + (size_t)(u.pm * BM + tid) * 4; float t = 0.f;
#pragma unroll
            for (int q = 0; q < 4; ++q) t += __hip_atomic_load(sl + q, __ATOMIC_RELAXED, __HIP_MEMORY_SCOPE_AGENT);
            S[tid] = rsqrtf(t * (1.0f / DM) + EPS); }
        asm volatile("s_waitcnt lgkmcnt(0)" ::: "memory"); __builtin_amdgcn_s_barrier(); asm volatile("" ::: "memory");
        const float* scp = nxsc + (size_t)b * (NMOD * DM); const float* shp = nxsh + (size_t)b * (NMOD * DM);
        f32x4 A4[2][2], B4[2][2];
#pragma unroll
        for (int bj = 0; bj < 2; ++bj)
#pragma unroll
            for (int n = 0; n < 2; ++n) { const int c = col0 + bj * HALF + n * 4; A4[bj][n] = *(const f32x4*)(nxg + c) * (*(const f32x4*)(scp + c) + 1.0f); B4[bj][n] = *(const f32x4*)(shp + c); }
#pragma unroll
        for (int ai = 0; ai < 2; ++ai)
#pragma unroll
            for (int m = 0; m < 4; ++m) { const int rl = ai * HALF + wr * 64 + m * 16 + fr; const float r = S[rl]; bf16_t* up = U + (size_t)(u.pm * BM + rl) * DM + col0;
#pragma unroll
                for (int bj = 0; bj < 2; ++bj) { const f32x4 y0 = acc[ai][bj][m][0] * r * A4[bj][0] + B4[bj][0], y1 = acc[ai][bj][m][1] * r * A4[bj][1] + B4[bj][1];
                    u32x4 w; w.x = cvtpk(y0[0], y0[1]); w.y = cvtpk(y0[2], y0[3]); w.z = cvtpk(y1[0], y1[1]); w.w = cvtpk(y1[2], y1[3]);
                    *(u32x4*)(up + bj * HALF) = w; } }
    }
};
struct EpiCmp {
    static constexpr bool PERM = true;
    float* O;
    __device__ __forceinline__ void operator()(const f32x4 (&acc)[2][2][4][2], const Unit& u, int wr, int wc, int fr, int fq) const {
        const bool isv = u.pm >= 16; const int row0 = u.pm * BM + wr * 64 + fr, col0 = wc * 32 + 8 * fq;
        float* ob = O + (size_t)u.pn * 8192 * 128;
#pragma unroll
        for (int ai = 0; ai < 2; ++ai)
#pragma unroll
            for (int m = 0; m < 4; ++m) { float* rowp = ob + (size_t)(row0 + ai * HALF + m * 16) * 128 + col0;
                *(f32x4*)rowp = isv ? acc[ai][1][m][0] : acc[ai][0][m][0]; *(f32x4*)(rowp + 4) = isv ? acc[ai][1][m][1] : acc[ai][0][m][1]; }
    }
};

template <class Epi>
__device__ __forceinline__ void gemm_phase(LAS unsigned char* lds, const Gemm g, const StaticOrder& S, const Epi& E) {
    int tid_ = threadIdx.x; asm volatile("" : "+v"(tid_));
    const int tid = tid_, wid = __builtin_amdgcn_readfirstlane(tid >> 6), lane = tid & 63, wr = wid >> 2, wc = wid & 3, fr = lane & 15, fq = lane >> 4;
    const int K = g.K, nt = K / BK;
    unsigned voffA[2], voffB[2];
#pragma unroll
    for (int i = 0; i < 2; ++i) { int R, C; stage_rc(tid * 16 + i * 8192, R, C); const int Rb = Epi::PERM ? ((R & ~31) + perm32(R & 31)) : R;
        voffA[i] = (unsigned)(R * g.lda + C) * 2u; voffB[i] = (unsigned)(Rb * g.ldb + C) * 2u; }
    const size_t kstep = (size_t)(BK * 2);
    const size_t hstepA = (size_t)HALF * g.lda * 2, hstepB = (size_t)HALF * g.ldb * 2;
    const size_t tstepA = 2 * hstepA, tstepB = 2 * hstepB;
    const unsigned ldsw = (unsigned)wid * 1024u;
    const int aoff = lds_byte(wr * 64 + fr, fq * 8), boff = lds_byte(wc * 32 + fr, fq * 8);
#define PG8_SA(b, h) (((b) * 2 + (h)) * HTB)
#define PG8_SB(b, h) ((4 + (b) * 2 + (h)) * HTB)
#define PG8_STAGE(bufoff, gbase, voff) do { _Pragma("unroll") for (int _i = 0; _i < 2; ++_i) \
        __builtin_amdgcn_global_load_lds((const unsigned*)((const char*)(gbase) + (voff)[_i]), (LAS unsigned*)(lds + (bufoff) + ldsw + _i * 8192), 16, 0, 0); } while (0)
#define PG8_LDA(dst, b, h) do { _Pragma("unroll") for (int m = 0; m < 4; ++m) _Pragma("unroll") for (int k = 0; k < 2; ++k) dst[m][k] = *(const LAS bf16x8*)(lds + PG8_SA(b, h) + aoff + m * 2048 + k * 1024); } while (0)
#define PG8_LDB(dst, b, h) do { _Pragma("unroll") for (int n = 0; n < 2; ++n) _Pragma("unroll") for (int k = 0; k < 2; ++k) dst[n][k] = *(const LAS bf16x8*)(lds + PG8_SB(b, h) + boff + n * 2048 + k * 1024); } while (0)
#define PG8_MMA(ai, bj, At, Bt) do { __builtin_amdgcn_s_setprio(1); _Pragma("unroll") for (int m = 0; m < 4; ++m) _Pragma("unroll") for (int n = 0; n < 2; ++n) _Pragma("unroll") for (int k = 0; k < 2; ++k) \
        acc[ai][bj][m][n] = __builtin_amdgcn_mfma_f32_16x16x32_bf16(Bt[n][k], At[m][k], acc[ai][bj][m][n], 0, 0, 0); __builtin_amdgcn_s_setprio(0); } while (0)
#define PG8_WAIT_V(n) asm volatile("s_waitcnt vmcnt(" #n ")" ::: "memory")
#define PG8_WAIT_L(n) asm volatile("s_waitcnt lgkmcnt(" #n ")" ::: "memory")
#define PG8_BAR __builtin_amdgcn_s_barrier()
#define PG8_SCHED __builtin_amdgcn_sched_barrier(0)
    Unit cur, nxt; int ui = 0;
    if (!S.next(0, cur)) return;
    f32x4 acc[2][2][4][2];
#pragma unroll
    for (int a = 0; a < 2; ++a)
#pragma unroll
        for (int b = 0; b < 2; ++b)
#pragma unroll
            for (int m = 0; m < 4; ++m)
#pragma unroll
                for (int n = 0; n < 2; ++n) acc[a][b][m][n] = (f32x4){0.f, 0.f, 0.f, 0.f};
    bf16x8 At[4][2], B0[2][2], B1[2][2];
    const size_t ksb = (size_t)g.ksb, bstep = g.ksb ? ksb : tstepB;
    const char* cA = (const char*)g.A + (size_t)cur.pm * tstepA + (size_t)cur.pn * ksb; const char* cB = (const char*)g.Bt + (size_t)cur.pn * bstep;
    PG8_STAGE(PG8_SB(0, 0), cB, voffB); PG8_STAGE(PG8_SB(0, 1), cB + hstepB, voffB); PG8_STAGE(PG8_SA(0, 0), cA, voffA); PG8_STAGE(PG8_SA(0, 1), cA + hstepA, voffA);
    if (wr == 1) PG8_BAR;
    PG8_WAIT_V(2); PG8_BAR;
    PG8_STAGE(PG8_SB(1, 0), cB + kstep, voffB); PG8_STAGE(PG8_SA(1, 0), cA + kstep, voffA); PG8_STAGE(PG8_SB(1, 1), cB + hstepB + kstep, voffB);
    PG8_WAIT_V(6); PG8_BAR;
    for (;;) {
        const bool has_next = S.next(ui + 1, nxt);
        const char* nA = has_next ? (const char*)g.A + (size_t)nxt.pm * tstepA + (size_t)nxt.pn * ksb : cA; const char* nB = has_next ? (const char*)g.Bt + (size_t)nxt.pn * bstep : cB;
        for (int t = 0; t < nt; t += 2) {
            const bool last = (t == nt - 2);
            const char* a1 = cA + (size_t)(t + 1) * kstep;
            const char* a2 = last ? nA : cA + (size_t)(t + 2) * kstep; const char* b2 = last ? nB : cB + (size_t)(t + 2) * kstep;
            const char* a3 = a2 + kstep; const char* b3 = b2 + kstep;
            PG8_LDB(B0, 0, 0); PG8_LDB(B1, 0, 1); PG8_SCHED; PG8_LDA(At, 0, 0); PG8_STAGE(PG8_SA(1, 1), a1 + hstepA, voffA);
            PG8_WAIT_V(8); PG8_WAIT_L(0); PG8_BAR; PG8_MMA(0, 0, At, B0); PG8_MMA(0, 1, At, B1); PG8_BAR; PG8_SCHED;
            PG8_LDA(At, 0, 1); PG8_STAGE(PG8_SB(0, 0), b2, voffB); PG8_STAGE(PG8_SB(0, 1), b2 + hstepB, voffB); PG8_STAGE(PG8_SA(0, 0), a2, voffA);
            PG8_WAIT_V(8); PG8_WAIT_L(0); PG8_BAR; PG8_MMA(1, 0, At, B0); PG8_MMA(1, 1, At, B1); PG8_BAR; PG8_SCHED;
            PG8_LDB(B0, 1, 0); PG8_LDB(B1, 1, 1); PG8_SCHED; PG8_LDA(At, 1, 0); PG8_STAGE(PG8_SA(0, 1), a2 + hstepA, voffA);
            PG8_WAIT_V(8); PG8_WAIT_L(0); PG8_BAR; PG8_MMA(0, 0, At, B0); PG8_MMA(0, 1, At, B1); PG8_BAR; PG8_SCHED;
            PG8_LDA(At, 1, 1); PG8_STAGE(PG8_SB(1, 0), b3, voffB); PG8_STAGE(PG8_SB(1, 1), b3 + hstepB, voffB); PG8_STAGE(PG8_SA(1, 0), a3, voffA);
            PG8_WAIT_V(8); PG8_WAIT_L(0); PG8_BAR; PG8_MMA(1, 0, At, B0); PG8_MMA(1, 1, At, B1); PG8_BAR; PG8_SCHED;
        }
        if (wr == 0) PG8_BAR;
        E(acc, cur, wr, wc, fr, fq);
        if (!has_next) break;
#pragma unroll
        for (int a = 0; a < 2; ++a)
#pragma unroll
            for (int b = 0; b < 2; ++b)
#pragma unroll
                for (int m = 0; m < 4; ++m)
#pragma unroll
                    for (int n = 0; n < 2; ++n) acc[a][b][m][n] = (f32x4){0.f, 0.f, 0.f, 0.f};
        cur = nxt; cA = nA; cB = nB; ++ui;
        if (wr == 1) PG8_BAR;
    }
    PG8_WAIT_V(0);
    PG8_BAR;
#undef PG8_SA
#undef PG8_SB
#undef PG8_STAGE
#undef PG8_LDA
#undef PG8_LDB
#undef PG8_MMA
#undef PG8_WAIT_V
#undef PG8_WAIT_L
#undef PG8_BAR
#undef PG8_SCHED
}
}

#define XB_TMO      128
#define XB_XCNT(j)  (256  + 64 * (j))
#define XB_XSUB(j)  (1280 + 64 * (j))
#define XB_XGEN(j)  (2304 + 64 * (j))
#define XB_TOP      3328
#define XB_TOPGEN   3392
#define XCD_BAR_WORDS 3456
#define XB_SPIN_CAP (1u << 18)
__device__ __forceinline__ unsigned xb_ld(unsigned* p)              { return __hip_atomic_load(p, __ATOMIC_RELAXED, __HIP_MEMORY_SCOPE_AGENT); }
__device__ __forceinline__ unsigned xb_add(unsigned* p, unsigned v) { return __hip_atomic_fetch_add(p, v, __ATOMIC_RELAXED, __HIP_MEMORY_SCOPE_AGENT); }
__device__ __forceinline__ unsigned xb_xcc_id() { return (unsigned)__builtin_amdgcn_s_getreg((3 << 11) | 20) & 0xFu; }
#define XB_SPIN(cond, bar) do { unsigned _sp = 0; while (cond) { __builtin_amdgcn_s_sleep(1); \
    if ((++_sp & 255u) == 0u) { if (xb_ld(&(bar)[XB_TMO])) break; if (_sp > XB_SPIN_CAP) { atomicAdd(&(bar)[XB_TMO], 1u); break; } } } } while (0)
struct XcdBarrier { unsigned* bar; unsigned x; volatile LAS unsigned* st; };
__device__ __forceinline__ XcdBarrier xcd_barrier_post(unsigned* bar, volatile LAS unsigned* st) {
    XcdBarrier b; b.bar = bar; b.x = xb_xcc_id(); b.st = st;
    if (threadIdx.x == 0) (void)xb_add(&bar[XB_XCNT(b.x)], 1u);
    return b;
}
__device__ __forceinline__ void xcd_barrier_complete(unsigned* bar, unsigned x, unsigned& nloc, unsigned& nx) {
    const unsigned G = gridDim.x * gridDim.y * gridDim.z;
    unsigned sum, cnt, mine, sp = 0u;
    for (;;) {
        sum = 0u; cnt = 0u; mine = 0u;
#pragma unroll
        for (unsigned j = 0; j < 16; ++j) { const unsigned c = xb_ld(&bar[XB_XCNT(j)]); sum += c; cnt += (c > 0u) ? 1u : 0u; mine = (j == x) ? c : mine; }
        if (sum == G) break;
        __builtin_amdgcn_s_sleep(1);
        if ((++sp & 255u) == 0u) { if (xb_ld(&bar[XB_TMO])) break; if (sp > XB_SPIN_CAP) { atomicAdd(&bar[XB_TMO], 1u); break; } }
    }
    nloc = mine > 0u ? mine : 1u; nx = cnt > 0u ? cnt : 1u;
}
__device__ __forceinline__ void xcd_barrier(const XcdBarrier& b) {
    asm volatile("s_waitcnt vmcnt(0)" ::: "memory");
    __syncthreads();
    if (threadIdx.x == 0) {
        unsigned* bar = b.bar;
        __builtin_amdgcn_s_waitcnt(0);
        unsigned nloc = b.st[0], nx = b.st[1];
        if (nloc == 0u) { xcd_barrier_complete(bar, b.x, nloc, nx); b.st[0] = nloc; b.st[1] = nx; }
        const unsigned old = xb_add(&bar[XB_XSUB(b.x)], 1u);
        const unsigned gen = old / nloc;
        if (old + 1u == (gen + 1u) * nloc) {
            __builtin_amdgcn_fence(__ATOMIC_RELEASE, "agent");
            asm volatile("s_waitcnt vmcnt(0)" ::: "memory");
            const unsigned og = xb_add(&bar[XB_TOP], 1u);
            const unsigned tg = og / nx;
            if (og + 1u == (tg + 1u) * nx) xb_add(&bar[XB_TOPGEN], 1u);
            else XB_SPIN(xb_ld(&bar[XB_TOPGEN]) == tg, bar);
            __builtin_amdgcn_fence(__ATOMIC_ACQUIRE, "agent");
            xb_add(&bar[XB_XGEN(b.x)], 1u);
            asm volatile("s_waitcnt vmcnt(0)" ::: "memory");
        } else {
            XB_SPIN(xb_ld(&bar[XB_XGEN(b.x)]) == gen, bar);
            __builtin_amdgcn_fence(__ATOMIC_ACQUIRE, "agent");
            asm volatile("s_waitcnt vmcnt(0)" ::: "memory");
        }
    }
    __syncthreads();
}

struct Params {
    const float* x; const float* c; const int* pos; const float* ada_w; const float* ada_b; const float* norm_g;
    const float* ffn_w_in; const float* ffn_w_out; const float* w_in; const float* w_out; const float* a_sinks; const float* a_qk_g;
    const float* b_q_lat_g; const float* b_kv_lat_g; const float* b_w_uq; const float* b_w_ukv; const float* b_qk_nope_g; const float* b_qk_rope_g;
    const float* c_qk_g; const float* c_cmp_pe; const float* c_cmp_w1; const float* c_cmp_w2; const float* c_gate_w; const float* c_gate_b;
    float* out; unsigned char* ws; int ph_lo, ph_hi;
};

__device__ __forceinline__ void transpose_item(const float* __restrict__ W, int Nsrc, int src_col0, bf16_t* WT, int K, int dst_row0, int k0, LAS float* scr, int lane, int nvalid = 32) {
    f32x4 v[8];
    if (src_col0 >= 0 && 4 * (lane & 7) < nvalid) {
        const float* wp = W + (size_t)(k0 + (lane >> 3)) * Nsrc + src_col0 + 4 * (lane & 7);
#pragma unroll
        for (int i = 0; i < 8; ++i) v[i] = *(const f32x4*)(wp + (size_t)(8 * i) * Nsrc);
    } else {
#pragma unroll
        for (int i = 0; i < 8; ++i) v[i] = (f32x4){0.f, 0.f, 0.f, 0.f};
    }
#pragma unroll
    for (int i = 0; i < 8; ++i) { LAS float* d = scr + (8 * i + (lane >> 3)) * 33 + 4 * (lane & 7); d[0] = v[i].x; d[1] = v[i].y; d[2] = v[i].z; d[3] = v[i].w; }
    LDS_WAIT();
    const int c = lane & 7;
#pragma unroll
    for (int j = 0; j < 4; ++j) { const int n = (lane >> 3) + 8 * j; const LAS float* s = scr + (8 * c) * 33 + n;
        u32x4 o; o.x = pk2(s[0 * 33], s[1 * 33]); o.y = pk2(s[2 * 33], s[3 * 33]); o.z = pk2(s[4 * 33], s[5 * 33]); o.w = pk2(s[6 * 33], s[7 * 33]);
        *(u32x4*)(WT + (size_t)(dst_row0 + n) * K + k0 + 8 * c) = o; }
    LDS_WAIT();
}
__device__ __forceinline__ int win_src_col(int c) {
    if (c < 512) return c;
    if (c < 1024) return 928 + (c - 512);
    if (c < 1792) return 1440 + (c - 1024);
    if (c < 2048) return 512 + (c - 1792);
    if (c < 2176) return 768 + (c - 2048);
    if (c < 2208) return 896 + (c - 2176);
    if (c < 2272) return 2208 + (c - 2208);
    return -1;
}
__device__ __forceinline__ void prologue(const Params& p, LAS unsigned char* lds, int tid, int wave, int lane, int G) {
    unsigned char* ws = p.ws;
    {
        LAS float* scr = (LAS float*)(lds + wave * 8448);
        const int gw = blockIdx.x * NWAVES + wave, NGW = G * NWAVES;
        constexpr int I1 = 8 * 16 * 176, I2 = 8 * 44 * 32, I3 = 4 * 16 * 72, I4 = 4 * 16 * 32, I5 = 4 * 4 * 16, I6 = 4 * 2 * 16, I7 = 8 * 32 * 4;
        constexpr int NITEMS = I1 + I2 + I3 + I4 + I5 + I6 + I7;
        for (int it = gw; it < NITEMS; it += NGW) {
            int r = it;
            if (r < I1) { const int m = r / 2816, q = r % 2816, kb = q / 176, nb = q % 176, pn = nb >> 3, wi = nb & 7;
                const int src = wi < 4 ? 128 * pn + 32 * wi : DFF + 128 * pn + 32 * (wi - 4);
                transpose_item(p.ffn_w_in + (size_t)m * DM * 2 * DFF, 2 * DFF, src, (bf16_t*)(ws + WS_W1T) + (size_t)m * 2 * DFF * DM, DM, nb * 32, kb * 64, scr, lane); continue; }
            r -= I1;
            if (r < I2) { const int m = r / 1408, q = r % 1408, kb = q / 32, nb = q % 32;
                transpose_item(p.ffn_w_out + (size_t)m * DFF * DM, DM, nb * 32, (bf16_t*)(ws + WS_W2T) + (size_t)m * DM * DFF, DFF, nb * 32, kb * 64, scr, lane); continue; }
            r -= I2;
            if (r < I3) { const int m = r / 1152, q = r % 1152, kb = q / 72, nb = q % 72;
                transpose_item(p.w_in + (size_t)m * DM * DIN, DIN, win_src_col(nb < 56 ? (nb >> 3) * 256 + 64 * (nb & 3) + 32 * ((nb >> 2) & 1) : nb * 32),     (bf16_t*)(ws + WS_WINT) + (size_t)m * DINP * DM, DM, nb * 32, kb * 64, scr, lane); continue; }
            r -= I3;
            if (r < I4) { const int m = r / 512, q = r % 512, kb = q / 32, nb = q % 32;
                transpose_item(p.w_out + (size_t)m * DM * DM, DM, nb * 32, (bf16_t*)(ws + WS_WOUTT) + (size_t)m * DM * DM, DM, nb * 32, kb * 64, scr, lane); continue; }
            r -= I4;
            if (r < I5) { const int m = r / 64, q = r % 64, kb = q / 16, nb = q % 16;
                transpose_item(p.b_w_uq + (size_t)m * 256 * 384, 384, nb < 8 ? 96 * (nb & 3) + 32 * (nb >> 2) : 96 * (nb & 3) + 64 + 16 * ((nb - 8) >> 2), (bf16_t*)(ws + WS_WUQT) + (size_t)m * 512 * 256, 256, nb * 32, kb * 64, scr, lane, nb < 8 ? 32 : 16); continue; }
            r -= I5;
            if (r < I6) { const int m = r / 32, q = r % 32, kb = q / 16, nb = q % 16;
                transpose_item(p.b_w_ukv + (size_t)m * 128 * 512, 512, 128 * (2 * (nb >> 3) + ((nb & 3) >> 1)) + 64 * (nb & 1) + 32 * ((nb >> 2) & 1), (bf16_t*)(ws + WS_WUKVT) + (size_t)m * 512 * 128, 128, nb * 32, kb * 64, scr, lane); continue; }
            r -= I6;
            { const int m = r / 128, q = r % 128, kb = q / 4, nb = q % 4;
                transpose_item(p.c_cmp_w1 + (size_t)m * 2048 * 128, 128, nb * 32, (bf16_t*)(ws + WS_WC1T) + (size_t)(m >> 1) * 256 * 2048, 2048, (m & 1) * 128 + nb * 32, kb * 64, scr, lane); }
        }
    }
    __syncthreads();
    {
        LAS float* cond = (LAS float*)lds;
        LAS float* red = (LAS float*)(lds + 32768);
        for (int i = tid; i < NBATCH * DM; i += NTHREADS) { const float cv = p.c[i]; cond[i] = cv / (1.0f + __expf(-cv)); }
        __syncthreads();
        const int col = tid & 63, ks = tid >> 6;
        float* MOD = (float*)(ws + WS_MOD);
        LAS float* red2 = (LAS float*)(lds + 32768);
        const int c4 = tid & 15, k32 = tid >> 4;
        for (int unit = blockIdx.x; unit < DEPTH * 144; unit += G) {
            const int l = unit / 144, n0 = (unit % 144) * 64;
            const float* Wp = p.ada_w + (size_t)l * DM * (NMOD * DM) + n0 + 4 * c4;
            f32x4 acc[8];
#pragma unroll
            for (int r = 0; r < 8; ++r) acc[r] = (f32x4){0.f, 0.f, 0.f, 0.f};
#pragma unroll 8
            for (int k = k32 * 32; k < k32 * 32 + 32; ++k) { const f32x4 w = *(const f32x4*)(Wp + (size_t)k * (NMOD * DM));
#pragma unroll
                for (int r = 0; r < 8; ++r) acc[r] += w * cond[r * DM + k]; }
#pragma unroll
            for (int r = 0; r < 8; ++r) { LAS float* d = red2 + (k32 * 8 + r) * 64 + 4 * c4; d[0] = acc[r].x; d[1] = acc[r].y; d[2] = acc[r].z; d[3] = acc[r].w; }
            __syncthreads();
            { const int r = tid >> 6; float v = 0.f;
#pragma unroll
              for (int k2 = 0; k2 < 32; ++k2) v += red2[(k2 * 8 + r) * 64 + col];
              MOD[((size_t)l * NBATCH + r) * (NMOD * DM) + n0 + col] = v + p.ada_b[(size_t)l * (NMOD * DM) + n0 + col]; }
            __syncthreads();
        }
        float* CMPBP = (float*)(ws + WS_CMPBP);
        for (int unit = (int)((blockIdx.x + G / 2) % G); unit < 256; unit += G) {
            const int m = unit >> 5, sl = unit & 31, cc = tid & 127, kq = tid >> 7;
            const float* pe = p.c_cmp_pe + (size_t)m * 2048 + sl * 64 + kq * 16; const float* w1 = p.c_cmp_w1 + ((size_t)m * 2048 + sl * 64 + kq * 16) * 128 + cc;
            float a = 0.f;
#pragma unroll
            for (int k = 0; k < 16; ++k) a += pe[k] * w1[(size_t)k * 128];
            red[kq * 128 + cc] = a;
            __syncthreads();
            if (tid < 128) CMPBP[(size_t)unit * 128 + tid] = (red[tid] + red[128 + tid]) + (red[256 + tid] + red[384 + tid]);
            __syncthreads();
        }
    }
    {
        float* C64 = (float*)(ws + WS_COS64); float* S64 = (float*)(ws + WS_SIN64); float* C32 = (float*)(ws + WS_COS32); float* S32 = (float*)(ws + WS_SIN32);
        for (int idx = blockIdx.x * NTHREADS + tid; idx < T * 32; idx += G * NTHREADS) {
            const int tok = idx >> 5, i = idx & 31; const float posf = (float)p.pos[tok];
            { const float inv = 1.0f / powf(10000.0f, (float)(2 * i) / 64.0f); const float ang = posf * inv;
              double rev = (double)ang * 0.15915494309189535; rev -= rint(rev); const float rr = (float)(rev * 6.283185307179586);
              C64[idx] = cosf(rr); S64[idx] = sinf(rr); }
            if (i < 16) { const float inv = 1.0f / powf(10000.0f, (float)(2 * i) / 32.0f); const float ang = posf * inv;
              double rev = (double)ang * 0.15915494309189535; rev -= rint(rev); const float rr = (float)(rev * 6.283185307179586);
              C32[tok * 16 + i] = cosf(rr); S32[tok * 16 + i] = sinf(rr); }
        }
        if (blockIdx.x == 0) { unsigned* z = (unsigned*)(ws + WS_R2 + R2_ZV + 8 * MiB); for (int i = tid; i < 4096; i += NTHREADS) z[i] = 0u; }
    }
}

__device__ __forceinline__ void norm_phase(const float* hin, bf16_t* U, const float* g, const float* modl, int sc_i, int sh_i, int gw, int ngw, int lane) {
    const int b = gw & 7, r0 = gw >> 3, rs = ngw >> 3;
    const float* scp = modl + (size_t)b * (NMOD * DM) + sc_i * DM; const float* shp = modl + (size_t)b * (NMOD * DM) + sh_i * DM;
    f32x4 A[4], B[4];
#pragma unroll
    for (int j = 0; j < 4; ++j) { const int col = 4 * lane + 256 * j; A[j] = *(const f32x4*)(g + col) * (*(const f32x4*)(scp + col) + 1.0f); B[j] = *(const f32x4*)(shp + col); }
    f32x4 v[4], nv[4], mv[4];
    if (r0 < SEQ) { const f32x4* xr = (const f32x4*)(hin + (size_t)(b * SEQ + r0) * DM) + lane;
#pragma unroll
        for (int j = 0; j < 4; ++j) v[j] = xr[64 * j]; }
    if (r0 + rs < SEQ) { const f32x4* xr = (const f32x4*)(hin + (size_t)(b * SEQ + r0 + rs) * DM) + lane;
#pragma unroll
        for (int j = 0; j < 4; ++j) nv[j] = xr[64 * j]; }
    for (int r = r0; r < SEQ; r += rs) {
        const int row = b * SEQ + r;
        if (r + 2 * rs < SEQ) { const f32x4* xr = (const f32x4*)(hin + (size_t)(row + 2 * rs) * DM) + lane;
#pragma unroll
            for (int j = 0; j < 4; ++j) mv[j] = xr[64 * j]; }
        float ss = 0.f;
#pragma unroll
        for (int j = 0; j < 4; ++j) ss += (v[j].x * v[j].x + v[j].y * v[j].y) + (v[j].z * v[j].z + v[j].w * v[j].w);
        const float rr = rsqrtf(wave_sum(ss) * (1.0f / DM) + EPS);
#pragma unroll
        for (int j = 0; j < 4; ++j) { const f32x4 y = (v[j] * rr) * A[j] + B[j];
            u32x2 w; w.x = cvtpk(y.x, y.y); w.y = cvtpk(y.z, y.w);
            *(u32x2*)(U + (size_t)row * DM + 4 * lane + 256 * j) = w; }
#pragma unroll
        for (int j = 0; j < 4; ++j) { v[j] = nv[j]; nv[j] = mv[j]; }
    }
}

__device__ __forceinline__ void unpack4(const u32x2 r, float (&f)[4]) { f[0] = __builtin_bit_cast(float, r.x << 16); f[1] = __builtin_bit_cast(float, r.x & 0xffff0000u); f[2] = __builtin_bit_cast(float, r.y << 16); f[3] = __builtin_bit_cast(float, r.y & 0xffff0000u); }
__device__ __forceinline__ u32x2 pack4(const float (&f)[4]) { u32x2 w; w.x = cvtpk(f[0], f[1]); w.y = cvtpk(f[2], f[3]); return w; }
__device__ __forceinline__ float sumsq8(const float (&a)[4], const float (&b)[4]) { return ((a[0] * a[0] + a[1] * a[1]) + (a[2] * a[2] + a[3] * a[3])) + ((b[0] * b[0] + b[1] * b[1]) + (b[2] * b[2] + b[3] * b[3])); }
__device__ __forceinline__ void load4g(const float* g, float (&o)[4]) { const f32x4 t = *(const f32x4*)g; o[0] = t.x; o[1] = t.y; o[2] = t.z; o[3] = t.w; }
__device__ __forceinline__ void ones4(float (&o)[4]) { o[0] = 1.f; o[1] = 1.f; o[2] = 1.f; o[3] = 1.f; }
__device__ __forceinline__ void scale_rope(float (&a)[4], float (&b)[4], float r, const float (&ga)[4], const float (&gb)[4], bool rope, const f32x4& cs, const f32x4& sn) {
#pragma unroll
    for (int e = 0; e < 4; ++e) { const float ya = a[e] * r * ga[e], yb = b[e] * r * gb[e];
        a[e] = rope ? ya * cs[e] - yb * sn[e] : ya; b[e] = rope ? yb * cs[e] + ya * sn[e] : yb; }
}
__device__ __forceinline__ void postproc_a2(const Params& p, LAS unsigned char* lds, int l, int gw, int ngw, int lane) {
    unsigned char* ws = p.ws; unsigned char* r2 = ws + WS_R2;
    const bf16_t* P2 = (const bf16_t*)(ws + WS_R1);
    bf16_t *CQN = (bf16_t*)(r2 + R2_CQN), *CKVN = (bf16_t*)(r2 + R2_CKVN), *KPE = (bf16_t*)(r2 + R2_KPE);
    float* GATES = (float*)(r2 + R2_GATES);
    const float* C32 = (const float*)(ws + WS_COS32); const float* S32 = (const float*)(ws + WS_SIN32);
    const int j = lane & 7, j4 = lane & 3;
    const int kind = lane < 32 ? 0 : (lane < 48 ? 1 : (lane < 52 ? 2 : (lane < 60 ? 3 : 4)));
    const int offA = kind == 0 ? 64 * (lane >> 3) + 4 * j : (kind == 1 ? 256 + 64 * ((lane - 32) >> 3) + 4 * j : (kind == 2 ? 384 + 4 * j4 : (kind == 3 ? 416 + 8 * (lane - 52) : 480)));
    const int offB = kind <= 1 ? offA + 32 : (kind == 2 ? offA + 16 : offA + 4);
    float ga[4], gb[4];
    if (kind == 0) { const float* gp = p.b_q_lat_g + l * 256 + offA; load4g(gp, ga); load4g(gp + 32, gb); }
    else if (kind == 1) { const float* gp = p.b_kv_lat_g + l * 128 + (offA - 256); load4g(gp, ga); load4g(gp + 32, gb); }
    else if (kind == 2) { const float* gp = p.b_qk_rope_g + (l * 2 + 1) * 32 + 4 * j4; load4g(gp, ga); load4g(gp + 16, gb); }
    else { ones4(ga); ones4(gb); }
    bf16_t* dst = kind == 0 ? CQN + offA : (kind == 1 ? CKVN + (offA - 256) : KPE + 4 * j4); const int ts = kind == 0 ? 256 : (kind == 1 ? 128 : 32), bo = kind == 2 ? 16 : 32;
    const int jj = lane < 24 ? lane : 23;
    LAS float* gwl = (LAS float*)lds;
    __syncthreads();
    { int t_ = threadIdx.x; asm volatile("" : "+v"(t_)); for (int i = t_; i < 64 * 24; i += NTHREADS) gwl[i] = p.c_gate_w[(size_t)l * 64 * 24 + i]; }
    __syncthreads();
    const float gbias = p.c_gate_b[l * 24 + jj];
    u32x2 ra, rb, na, nb;
    if (gw < T) { ra = *(const u32x2*)(P2 + (size_t)gw * 512 + offA); rb = *(const u32x2*)(P2 + (size_t)gw * 512 + offB); }
    for (int tok = gw; tok < T; tok += ngw) {
        if (tok + ngw < T) { na = *(const u32x2*)(P2 + (size_t)(tok + ngw) * 512 + offA); nb = *(const u32x2*)(P2 + (size_t)(tok + ngw) * 512 + offB); }
        const f32x4 cs32 = *(const f32x4*)(C32 + (size_t)tok * 16 + 4 * j4), sn32 = *(const f32x4*)(S32 + (size_t)tok * 16 + 4 * j4);
        float a[4], bb[4];
        unpack4(ra, a); unpack4(rb, bb);
        float ss = sumsq8(a, bb); ss += __shfl_xor(ss, 1); ss += __shfl_xor(ss, 2);
        float s16 = ss; s16 += __shfl_xor(s16, 4); s16 += __shfl_xor(s16, 8);
        float s32 = s16; s32 += __shfl_xor(s32, 16);
        float sg[8];
#pragma unroll
        for (int e = 0; e < 4; ++e) { sg[e] = silu_f(a[e]); sg[4 + e] = silu_f(bb[e]); }
        const float r = kind == 0 ? rsqrtf(s32 * (1.0f / 256) + EPS) : (kind == 1 ? rsqrtf(s16 * (1.0f / 128) + EPS) : rsqrtf(ss * (1.0f / 32) + EPS));
        scale_rope(a, bb, r, ga, gb, kind == 2, cs32, sn32);
        if (kind <= 2) { bf16_t* d = dst + (size_t)tok * ts; *(u32x2*)d = pack4(a); *(u32x2*)(d + bo) = pack4(bb); }
        float acc = gbias;
#pragma unroll
        for (int k = 0; k < 64; ++k) acc += __builtin_bit_cast(float, __builtin_amdgcn_readlane(__builtin_bit_cast(int, sg[k & 7]), 52 + (k >> 3))) * gwl[k * 24 + jj];
        if (lane < 24) GATES[(size_t)tok * 24 + lane] = 1.0f / (1.0f + __expf(-acc));
        ra = na; rb = nb;
    }
}

__device__ __forceinline__ void postproc_b(const Params& p, LAS unsigned char* lds, int l, int gw, int ngw, int lane) {
    unsigned char* ws = p.ws; unsigned char* r1 = ws + WS_R1; unsigned char* r2 = ws + WS_R2;
    bf16_t *KCMP = (bf16_t*)(r2 + R2_KCMP), *VCMP = (bf16_t*)(r2 + R2_VCMP);
    const float* HIDP = (const float*)(r1 + R1_HIDP); const float* CMPB = (const float*)(ws + WS_CMPB);
    const float gck = p.c_qk_g[(l * 4 + 1) * 64 + lane];
    LAS float* w2l = (LAS float*)lds;
    __syncthreads();
    { int t_ = threadIdx.x; asm volatile("" : "+v"(t_)); const f32x4* src = (const f32x4*)(p.c_cmp_w2 + (size_t)l * 2 * 128 * 64);
      for (int i = t_; i < 2 * 128 * 64 / 4; i += NTHREADS) ((LAS f32x4*)w2l)[i] = src[i]; }
    __syncthreads();
    for (int r = gw; r < 8192; r += ngw) {
        const int kv = r >> 12, rr = r & 4095, i = rr & 255;
        const LAS float* w2 = w2l + kv * 128 * 64 + lane;
        float hs0 = CMPB[(l * 2 + kv) * 128 + lane], hs1 = CMPB[(l * 2 + kv) * 128 + 64 + lane];
#pragma unroll
        for (int sl = 0; sl < 4; ++sl) { hs0 += HIDP[((size_t)sl * 8192 + r) * 128 + lane]; hs1 += HIDP[((size_t)sl * 8192 + r) * 128 + 64 + lane]; }
        const int h0 = __builtin_bit_cast(int, bf2f(f2bf(silu_f(hs0)))), h1 = __builtin_bit_cast(int, bf2f(f2bf(silu_f(hs1))));
        float a = 0.f;
#pragma unroll
        for (int k = 0; k < 64; ++k) a += __builtin_bit_cast(float, __builtin_amdgcn_readlane(h0, k)) * w2[k * 64];
#pragma unroll
        for (int k = 0; k < 64; ++k) a += __builtin_bit_cast(float, __builtin_amdgcn_readlane(h1, k)) * w2[(64 + k) * 64];
        if (kv == 0) { float y = a * rsqrtf(wave_sum(a * a) * (1.0f / 64) + EPS) * gck; if (i == 255) y = 0.f; KCMP[(size_t)rr * 64 + lane] = (bf16_t)f2bf(y); }
        else { if (i == 255) a = 0.f; VCMP[(size_t)rr * 64 + lane] = (bf16_t)f2bf(a); }
    }
}

constexpr int VPITCH = 160;
constexpr int AL_K = 0, AL_V = 13312, AL_BUF = 13312 + 64 * VPITCH, AL_IMP = 4 * AL_BUF, AL_UNI = 4 * AL_BUF + 33280;
#define MFMA16(a, b, c) __builtin_amdgcn_mfma_f32_16x16x32_bf16((a), (b), (c), 0, 0, 0)

template <int NC>
__device__ __forceinline__ void attn_s_pair(const LAS unsigned char* Ks, const bf16x8 (&q0)[NC], const bf16x8 (&q1)[NC], f32x4 (&s)[2][4], int fr, int fq, float i0 = 0.f, float i1 = 0.f) {
    constexpr int PITCHB = (32 * NC + 8) * 2;
#pragma unroll
    for (int kb = 0; kb < 4; ++kb) {
        s[0][kb] = (f32x4){i0, i0, i0, i0}; s[1][kb] = (f32x4){i1, i1, i1, i1};
#pragma unroll
        for (int c = 0; c < NC; ++c) {
            const bf16x8 kf = *(const LAS bf16x8*)(Ks + (16 * kb + fr) * PITCHB + (32 * c + 8 * fq) * 2);
            s[0][kb] = MFMA16(kf, q0[c], s[0][kb]); s[1][kb] = MFMA16(kf, q1[c], s[1][kb]);
        }
    }
}
typedef short v4i16_t __attribute__((ext_vector_type(4)));
__device__ __forceinline__ bf16x4 vtr_read(const LAS unsigned char* p) { return __builtin_bit_cast(bf16x4, __builtin_amdgcn_ds_read_tr16_b64_v4i16((LAS v4i16_t*)p)); }
__device__ __forceinline__ void attn_pv_pair(const LAS unsigned char* Vs, const bf16x8 (&pf)[2][2], f32x4 (&o0)[4], f32x4 (&o1)[4], int fr, int fq) {
    const LAS unsigned char* vb = Vs + (4 * fq + (fr >> 2)) * VPITCH + 8 * (fr & 3);
#pragma unroll
    for (int db = 0; db < 4; ++db)
#pragma unroll
        for (int kc = 0; kc < 2; ++kc) {
            const bf16x4 lo = vtr_read(vb + (32 * kc) * VPITCH + 32 * db), hi = vtr_read(vb + (32 * kc + 16) * VPITCH + 32 * db);
            const bf16x8 vf = {lo.x, lo.y, lo.z, lo.w, hi.x, hi.y, hi.z, hi.w};
            o0[db] = MFMA16(vf, pf[0][kc], o0[db]); o1[db] = MFMA16(vf, pf[1][kc], o1[db]);
        }
}
__device__ __forceinline__ bf16x8 pack_p(const f32x4& a, const f32x4& b) {
    u32x4 w; w.x = cvtpk(a[0], a[1]); w.y = cvtpk(a[2], a[3]); w.z = cvtpk(b[0], b[1]); w.w = cvtpk(b[2], b[3]); return __builtin_bit_cast(bf16x8, w);
}
template <int NC>
__device__ __forceinline__ void tile_load(const bf16_t* Kb, const bf16_t* Vb, int t, u32x4& k0, u32x4& k1, u32x4& v, int tid, bool withV) {
    const unsigned ko = (unsigned)t * (64u * 32u * NC) + (unsigned)tid * 8u, vo = (unsigned)t * 4096u + (unsigned)tid * 8u;
    k0 = *(const u32x4*)(Kb + ko);
    if (NC == 3) { if (tid < 256) k1 = *(const u32x4*)(Kb + ko + 4096u); }
    if (withV) v = *(const u32x4*)(Vb + vo);
}
template <int NC>
__device__ __forceinline__ void tile_store(LAS unsigned char* lds, const u32x4& k0, const u32x4& k1, const u32x4& v, int tid, bool withV) {
    constexpr int CPK = 4 * NC, PITCHB = (32 * NC + 8) * 2;
    { const int key = tid / CPK, ch = tid % CPK; *(LAS u32x4*)(lds + AL_K + key * PITCHB + ch * 16) = k0; }
    if (NC == 3) { if (tid < 256) { const int cid = tid + 512, key = cid / CPK, ch = cid % CPK; *(LAS u32x4*)(lds + AL_K + key * PITCHB + ch * 16) = k1; } }
    if (withV) { const int key = tid >> 3, ch = tid & 7; *(LAS u32x4*)(lds + AL_V + key * VPITCH + ch * 16) = v; }
}

struct AttnPtrs { const bf16_t* Q; const bf16_t* K; const bf16_t* V; bf16_t* O; int ldo, col0; float c2, shiftC; const float* sinks; const unsigned long long* sel; const float* gates; const bf16_t* ocmp; const bf16_t* K2; const bf16_t* V2; float shift2; };
template <int MODE> struct ACfg;
template <> struct ACfg<0> { static constexpr int NC = 2, G = 2, H = 4, HKV = 2; };
template <> struct ACfg<1> { static constexpr int NC = 3, G = 1, H = 4, HKV = 4; };
template <> struct ACfg<2> { static constexpr int NC = 2, G = 4, H = 8, HKV = 2; };
template <> struct ACfg<3> { static constexpr int NC = 2, G = 4, H = 8, HKV = 2; };

template <int MODE, int SM>
__device__ __forceinline__ void attn_tile(const LAS unsigned char* Kl, const LAS unsigned char* Vl, const bf16x8 (&qf)[2][ACfg<MODE>::NC], f32x4 (&o)[2][4], f32x4 (&lacc)[2],
                                          int kt, int qw0, int fr, int fq, float shiftC, bool masked, unsigned selbits) {
    constexpr int NC = ACfg<MODE>::NC, G = ACfg<MODE>::G;
    f32x4 s[2][4];
    attn_s_pair<NC>(Kl, qf[0], qf[1], s, fr, fq, (selbits & 1u) ? -shiftC : -INFINITY, (selbits & 2u) ? -shiftC : -INFINITY);
    bf16x8 pf[2][2];
    const u32x4 onesw = {0x3f803f80u, 0x3f803f80u, 0x3f803f80u, 0x3f803f80u}; const bf16x8 ones = __builtin_bit_cast(bf16x8, onesw);
#pragma unroll
    for (int g = 0; g < 2; ++g) {
        if (masked) {
            const int qpos = (MODE == 3) ? qw0 + 4 * g + (fr >> 2) : qw0 + (G == 1 ? 16 * g : 0) + fr;
#pragma unroll
            for (int kb = 0; kb < 4; ++kb)
#pragma unroll
                for (int e = 0; e < 4; ++e) { const int key = 64 * kt + 16 * kb + 4 * fq + e; bool valid;
                    if (SM == 0) valid = (key <= qpos) && (key > qpos - 128);
                    else if (SM == 2) valid = (key <= qpos) && (key > qpos - 256);
                    else valid = key <= qpos;
                    s[g][kb][e] = valid ? s[g][kb][e] : -INFINITY; }
        }
#pragma unroll
        for (int kb = 0; kb < 4; ++kb)
#pragma unroll
            for (int e = 0; e < 4; ++e) s[g][kb][e] = fast_exp2(s[g][kb][e]);
        pf[g][0] = pack_p(s[g][0], s[g][1]); pf[g][1] = pack_p(s[g][2], s[g][3]);
        lacc[g] = MFMA16(ones, pf[g][0], lacc[g]); lacc[g] = MFMA16(ones, pf[g][1], lacc[g]);
    }
    attn_pv_pair(Vl, pf, o[0], o[1], fr, fq);
}

template <int MODE, int SM>
__device__ __forceinline__ void attn_stream(LAS unsigned char* lds, const bf16_t* Kb, const bf16_t* Vb, const bf16x8 (&qf)[2][ACfg<MODE>::NC], f32x4 (&o)[2][4], f32x4 (&lacc)[2],
                                            const unsigned long long* selp, int q0, int qw0, int qt, float sh_loc, int tid, int w, int lane, int fr, int fq) {
    typedef ACfg<MODE> C; constexpr int NC = C::NC, G = C::G;
    constexpr int QW = (MODE == 3) ? 8 : ((G == 1) ? 32 : 16), UQ = (G == 1) ? 256 : (G == 2 ? 128 : 64);
    int kt_lo = 0, kt_hi = 0; unsigned long long rem = 0ull, wuni = 0ull; unsigned s0lo = 0u, s0hi = 0u, s1lo = 0u, s1hi = 0u;
    if (SM == 0) { kt_lo = (q0 - 127) < 0 ? 0 : (q0 - 127) >> 6; kt_hi = (q0 + UQ - 1) >> 6; }
    if (SM == 1) { kt_lo = 0; kt_hi = (q0 + UQ - 1) >> 6; }
    if (SM == 2) { kt_lo = (q0 - 255) < 0 ? 0 : (q0 - 255) >> 6; kt_hi = (q0 + UQ - 1) >> 6; }
    __syncthreads();
    if (SM == 3) {
        const unsigned long long sel = selp[qw0 + (fr >> 2)], sel1 = selp[qw0 + 4 + (fr >> 2)];
        s0lo = (unsigned)sel; s0hi = (unsigned)(sel >> 32); s1lo = (unsigned)sel1; s1hi = (unsigned)(sel1 >> 32);
        unsigned lo = s0lo | s1lo, hi = s0hi | s1hi;
#pragma unroll
        for (int off = 4; off < 16; off <<= 1) { lo |= __shfl_xor(lo, off); hi |= __shfl_xor(hi, off); }
        wuni = ((unsigned long long)(unsigned)__builtin_amdgcn_readfirstlane((int)hi) << 32) | (unsigned)__builtin_amdgcn_readfirstlane((int)lo);
        LAS unsigned* un = (LAS unsigned*)(lds + AL_UNI);
        if (lane == 0) { un[2 * w] = lo; un[2 * w + 1] = hi; }
        __syncthreads();
        unsigned ulo = 0, uhi = 0;
#pragma unroll
        for (int j = 0; j < 8; ++j) { ulo |= un[2 * j]; uhi |= un[2 * j + 1]; }
        rem = ((unsigned long long)(unsigned)__builtin_amdgcn_readfirstlane((int)uhi) << 32) | (unsigned)__builtin_amdgcn_readfirstlane((int)ulo);
    }
#define NEXT_TILE(dst, cur) do { if (SM == 3) { dst = rem ? (int)__builtin_ctzll(rem) : -1; rem &= rem - 1; } else dst = ((cur) >= 0 && (cur) < kt_hi) ? (cur) + 1 : -1; } while (0)
#define TILE_LOAD(t, K0, K1, V0) tile_load<NC>(Kb, Vb, (t), K0, K1, V0, tid, true)
#define TILE_COMPUTE(t, bufoff) do { \
        bool need_, full_; \
        if (SM == 0) { need_ = (64 * (t) + 63 > qw0 - 128) && (64 * (t) <= qw0 + QW - 1); full_ = (64 * (t) + 63 <= qw0) && (64 * (t) > qw0 + QW - 1 - 128); } \
        else if (SM == 1) { need_ = 64 * (t) <= qw0 + QW - 1; full_ = 64 * (t) + 63 <= qw0; } \
        else if (SM == 2) { need_ = (64 * (t) + 63 > qw0 - 256) && (64 * (t) <= qw0 + QW - 1); full_ = (64 * (t) + 63 <= qw0) && (64 * (t) > qw0 + QW - 1 - 256); } \
        else { need_ = ((wuni >> (t)) & 1ull) != 0ull; full_ = (t) != qt; }     \
        if (need_) { const unsigned selbit_ = (SM == 3) ? ((((((t) & 32) ? s0hi : s0lo) >> ((t) & 31)) & 1u) | ((((((t) & 32) ? s1hi : s1lo) >> ((t) & 31)) & 1u) << 1)) : 3u; \
            if (full_) attn_tile<MODE, SM>(lds + (bufoff) + AL_K, lds + (bufoff) + AL_V, qf, o, lacc, (t), qw0, fr, fq, sh_loc, false, selbit_); \
            else attn_tile<MODE, SM>(lds + (bufoff) + AL_K, lds + (bufoff) + AL_V, qf, o, lacc, (t), qw0, fr, fq, sh_loc, true, selbit_); } } while (0)
    int tq[6];
    if (SM == 3) { tq[0] = rem ? (int)__builtin_ctzll(rem) : -1; rem &= rem - 1; } else tq[0] = kt_lo;
#pragma unroll
    for (int k = 1; k < 4; ++k) NEXT_TILE(tq[k], tq[k - 1]);
    u32x4 rk0[2], rk1[2], rv[2];
    rk1[0] = (u32x4){0u, 0u, 0u, 0u}; rk1[1] = rk1[0];
#define LOADSET(u, t) do { const int tl_ = (t) < 0 ? 0 : (t); TILE_LOAD(tl_, rk0[u], rk1[u], rv[u]); } while (0)
    if (tq[0] >= 0) {
        LOADSET(0, tq[0]); LOADSET(1, tq[1]);
        tile_store<NC>(lds, rk0[0], rk1[0], rv[0], tid, true); tile_store<NC>(lds + AL_BUF, rk0[1], rk1[1], rv[1], tid, true);
        LOADSET(0, tq[2]); LOADSET(1, tq[3]);
        __syncthreads();
        for (;;) {
#pragma unroll
            for (int u = 0; u < 2; ++u) {
                const int cur = u ? 2 * AL_BUF : 0, nxt = u ? 0 : 2 * AL_BUF;
                tile_store<NC>(lds + nxt, rk0[0], rk1[0], rv[0], tid, true); tile_store<NC>(lds + nxt + AL_BUF, rk0[1], rk1[1], rv[1], tid, true);
                NEXT_TILE(tq[4], tq[3]); NEXT_TILE(tq[5], tq[4]);
                LOADSET(0, tq[4]); LOADSET(1, tq[5]);
                TILE_COMPUTE(tq[0], cur);
                if (tq[1] >= 0) TILE_COMPUTE(tq[1], cur + AL_BUF);
                __syncthreads();
#pragma unroll
                for (int k = 0; k < 4; ++k) tq[k] = tq[k + 2];
                if (tq[0] < 0) break;
            }
            if (tq[0] < 0) break;
        }
    }
#undef LOADSET
#undef NEXT_TILE
#undef TILE_LOAD
#undef TILE_COMPUTE
}

template <int MODE>
__device__ __forceinline__ void attn_flash(LAS unsigned char* lds, const AttnPtrs& a, int b, int hkv, int qt) {
    typedef ACfg<MODE> C; constexpr int NC = C::NC, G = C::G, DQ = 32 * NC;
    constexpr int QW = (G == 1) ? 32 : 16, UQ = (G == 1) ? 256 : (G == 2 ? 128 : 64);
    const float sh_loc = uniform_f(a.shiftC), sh2_loc = uniform_f(a.shift2); const int ldo_loc = __builtin_amdgcn_readfirstlane(a.ldo), col0_loc = __builtin_amdgcn_readfirstlane(a.col0);
    int tid_ = threadIdx.x; asm volatile("" : "+v"(tid_));
    const int tid = tid_, w = __builtin_amdgcn_readfirstlane(tid >> 6), lane = tid & 63, fr = lane & 15, fq = lane >> 4;
    const int q0 = qt * UQ, qw0 = q0 + (MODE == 3 ? 8 * w : QW * w);
    const int hbase = hkv * G;
    bf16x8 qf[2][NC];
#pragma unroll
    for (int i = 0; i < 2; ++i) { const int h = (MODE == 3) ? hkv * 4 + (fr & 3) : hbase + (G == 1 ? 0 : i), q = (MODE == 3) ? qw0 + 4 * i + (fr >> 2) : qw0 + (G == 1 ? 16 * i : 0) + fr;
        const bf16_t* qp = a.Q + ((size_t)(b * C::H + h) * SEQ + q) * DQ + 8 * fq;
#pragma unroll
        for (int c = 0; c < NC; ++c) qf[i][c] = *(const bf16x8*)(qp + 32 * c); }
    f32x4 o[2][4], lacc[2], ow[2][4], lw[2];
#pragma unroll
    for (int i = 0; i < 2; ++i) { lacc[i] = (f32x4){0.f, 0.f, 0.f, 0.f}; lw[i] = lacc[i];
#pragma unroll
        for (int d = 0; d < 4; ++d) { o[i][d] = (f32x4){0.f, 0.f, 0.f, 0.f}; ow[i][d] = o[i][d]; } }
    const size_t kvo = (size_t)(b * C::HKV + hkv) * SEQ;
    if (MODE == 3) attn_stream<MODE, 2>(lds, a.K2 + kvo * DQ, a.V2 + kvo * 64, qf, ow, lw, nullptr, q0, qw0, qt, sh2_loc, tid, w, lane, fr, fq);
    attn_stream<MODE, MODE>(lds, a.K + kvo * DQ, a.V + kvo * 64, qf, o, lacc, MODE == 3 ? a.sel + (size_t)(b * 2 + hkv) * SEQ : nullptr, q0, qw0, qt, sh_loc, tid, w, lane, fr, fq);
#pragma unroll
    for (int i = 0; i < 2; ++i) {
        const int hl = (MODE == 3) ? hkv * 4 + (fr & 3) : hbase + (G == 1 ? 0 : i), q = (MODE == 3) ? qw0 + 4 * i + (fr >> 2) : qw0 + (G == 1 ? 16 * i : 0) + fr;
        float lt = lacc[i][0];
        if (MODE == 0) { const float* sp_ = a.sinks; asm volatile("" : "+s"(sp_)); lt += fast_exp2(sp_[hl] * LOG2E - sh_loc); }
        const float inv = lt > 0.f ? 1.0f / lt : 0.f;
        const size_t tok = (size_t)b * SEQ + q;
        float g0 = 0.f, g1 = 0.f, g2 = 0.f;
        if (MODE == 3) { const float* gp = a.gates + tok * 24 + 3 * hl; const float lwv = lw[i][0]; g0 = gp[0]; g1 = gp[1] * inv; g2 = lwv > 0.f ? gp[2] / lwv : 0.f; }
#pragma unroll
        for (int db = 0; db < 4; ++db) {
            f32x4 v;
            const int col = 64 * hl + 16 * db + 4 * fq;
            if (MODE == 3) {
                const u32x2 c2_ = *(const u32x2*)(a.ocmp + tok * 512 + col);
                v[0] = g0 * bf2f(c2_.x & 0xffffu) + g1 * o[i][db][0] + g2 * ow[i][db][0];
                v[1] = g0 * bf2f(c2_.x >> 16) + g1 * o[i][db][1] + g2 * ow[i][db][1];
                v[2] = g0 * bf2f(c2_.y & 0xffffu) + g1 * o[i][db][2] + g2 * ow[i][db][2];
                v[3] = g0 * bf2f(c2_.y >> 16) + g1 * o[i][db][3] + g2 * ow[i][db][3];
            } else v = o[i][db] * inv;
            u32x2 wv; wv.x = cvtpk(v[0], v[1]); wv.y = cvtpk(v[2], v[3]);
            *(u32x2*)(a.O + tok * ldo_loc + col0_loc + col) = wv;
        }
    }
}

__device__ __forceinline__ void attn_cmp(LAS unsigned char* lds, const bf16_t* QC, const bf16_t* KCMP, const bf16_t* VCMP, bf16_t* OCMP, unsigned long long* SEL, float shiftC, int b, int hkv, int qt) {
    constexpr int NC = 2;
    int tid_ = threadIdx.x; asm volatile("" : "+v"(tid_));
    const int tid = tid_, w = __builtin_amdgcn_readfirstlane(tid >> 6), lane = tid & 63, fr = lane & 15, fq = lane >> 4;
    const int q0 = qt * 64, qw0 = q0 + 16 * (w >> 1), qpos = qw0 + fr, hbase = hkv * 4 + 2 * (w & 1);
    const float sh = uniform_f(shiftC);
    bf16x8 qf[2][NC];
#pragma unroll
    for (int i = 0; i < 2; ++i) { const bf16_t* qp = QC + ((size_t)(b * 8 + hbase + i) * SEQ + qpos) * 64 + 8 * fq;
#pragma unroll
        for (int c = 0; c < NC; ++c) qf[i][c] = *(const bf16x8*)(qp + 32 * c); }
    const bf16_t* Kb = KCMP + (size_t)(b * 2 + hkv) * 256 * 64; const bf16_t* Vb = VCMP + (size_t)(b * 2 + hkv) * 256 * 64;
    const int jb = q0 + 63 - 31;
    const int nt = ((jb >> 4) >> 6) + 1;
    const int jw = qw0 + 15 - 31;
    const int ntw = jw < 0 ? 0 : ((jw >> 4) >> 6) + 1;
    u32x4 kr[4], vr[4], dummy = (u32x4){0u, 0u, 0u, 0u};
#pragma unroll
    for (int kt = 0; kt < 4; ++kt) { const int tl = kt < nt ? kt : 0; tile_load<NC>(Kb, Vb, tl, kr[kt], dummy, vr[kt], tid, true); }
    __syncthreads();
#pragma unroll
    for (int kt = 0; kt < 4; ++kt) tile_store<NC>(lds + kt * AL_BUF, kr[kt], dummy, vr[kt], tid, true);
    LAS float* imp = (LAS float*)(lds + AL_IMP) + w * (16 * 65);
    for (int i = lane; i < 16 * 65; i += 64) imp[i] = 0.f;
    __syncthreads();
    f32x4 o[2][4], lacc[2];
#pragma unroll
    for (int i = 0; i < 2; ++i) { lacc[i] = (f32x4){0.f, 0.f, 0.f, 0.f};
#pragma unroll
        for (int d = 0; d < 4; ++d) o[i][d] = (f32x4){0.f, 0.f, 0.f, 0.f}; }
    float va[2][4][4], vb[2][4][4];
#pragma unroll
    for (int g = 0; g < 2; ++g)
#pragma unroll
        for (int kt = 0; kt < 4; ++kt)
#pragma unroll
            for (int kb = 0; kb < 4; ++kb) { va[g][kt][kb] = 0.f; vb[g][kt][kb] = 0.f; }
    const u32x4 onesw = {0x3f803f80u, 0x3f803f80u, 0x3f803f80u, 0x3f803f80u}; const bf16x8 ones = __builtin_bit_cast(bf16x8, onesw);
#pragma unroll
    for (int kt = 0; kt < 4; ++kt) {
        if (kt < ntw) {
            f32x4 s[2][4];
            attn_s_pair<NC>(lds + kt * AL_BUF + AL_K, qf[0], qf[1], s, fr, fq, -sh, -sh);
            bf16x8 pf[2][2];
#pragma unroll
            for (int g = 0; g < 2; ++g) {
#pragma unroll
                for (int kb = 0; kb < 4; ++kb) {
#pragma unroll
                    for (int e = 0; e < 4; ++e) { const int j = 64 * kt + 16 * kb + 4 * fq + e; const bool valid = (16 * j + 31 <= qpos) && (j < 255);
                        s[g][kb][e] = fast_exp2(valid ? s[g][kb][e] : -INFINITY); }
                    va[g][kt][kb] = (s[g][kb][0] + s[g][kb][1]) + (s[g][kb][2] + s[g][kb][3]); vb[g][kt][kb] = s[g][kb][3]; }
                pf[g][0] = pack_p(s[g][0], s[g][1]); pf[g][1] = pack_p(s[g][2], s[g][3]);
                lacc[g] = MFMA16(ones, pf[g][0], lacc[g]); lacc[g] = MFMA16(ones, pf[g][1], lacc[g]); }
            attn_pv_pair(lds + kt * AL_BUF + AL_V, pf, o[0], o[1], fr, fq);
        }
    }
    float invl[2];
#pragma unroll
    for (int i = 0; i < 2; ++i) { const float lt = lacc[i][0]; invl[i] = lt > 0.f ? 1.0f / lt : 0.f; }
#pragma unroll
    for (int i = 0; i < 2; ++i) { const size_t tok = (size_t)b * SEQ + qpos;
#pragma unroll
        for (int db = 0; db < 4; ++db) { const f32x4 v = o[i][db] * invl[i]; u32x2 wv; wv.x = cvtpk(v[0], v[1]); wv.y = cvtpk(v[2], v[3]);
            *(u32x2*)(OCMP + tok * 512 + 64 * (hbase + i) + 16 * db + 4 * fq) = wv; } }
    LDS_WAIT();
#pragma unroll
    for (int kt = 0; kt < 4; ++kt)
#pragma unroll
        for (int kb = 0; kb < 4; ++kb) imp[fr * 65 + 16 * kt + 4 * kb + fq] = va[0][kt][kb] * invl[0] + va[1][kt][kb] * invl[1];
    LDS_WAIT();
#pragma unroll
    for (int kt = 0; kt < 4; ++kt)
#pragma unroll
        for (int kb = 0; kb < 4; ++kb) { imp[fr * 65 + 16 * kt + 4 * kb + fq + 1] += vb[0][kt][kb] * invl[0] + vb[1][kt][kb] * invl[1]; LDS_WAIT(); }
    __syncthreads();
    const LAS float* impo = (const LAS float*)(lds + AL_IMP) + (w ^ 1) * (16 * 65);
#pragma unroll 1
    for (int r8 = 0; r8 < 8; ++r8) {
        const int r = 8 * (w & 1) + r8, q = qw0 + r, cur = q >> 6, sblk = lane;
        const float v = imp[r * 65 + lane] + impo[r * 65 + lane];
        const bool future = sblk > cur, forced = (sblk == 0) || (sblk == cur) || (sblk == cur - 1);
        unsigned key = forced ? 0x461C4000u : (__builtin_bit_cast(unsigned, v) & ~63u);
        key = future ? 0u : ((key | (unsigned)(63 - sblk)) + 64u);
        unsigned thr = 0u;
#pragma unroll
        for (int bit = 31; bit >= 0; --bit) { const unsigned cand = thr | (1u << bit); if (__popcll(__ballot(key >= cand)) >= 8) thr = cand; }
        const bool selb = (key >= thr) && (key != 0u);
        const unsigned long long mask = __ballot(selb);
        if (lane == 0) SEL[(size_t)(b * 2 + hkv) * SEQ + q] = mask;
    }
}

__device__ __forceinline__ void attn_phase_main(const Params& p, LAS unsigned char* lds, int l, int G) {
    unsigned char* ws = p.ws; unsigned char* r1 = ws + WS_R1; unsigned char* r2 = ws + WS_R2;
    bf16_t* O = (bf16_t*)(ws + WS_U);
    int tl_ = threadIdx.x; asm volatile("" : "+v"(tl_)); const int lane_ = tl_ & 63;
    const float gAq = wave_max(fabsf(p.a_qk_g[(l * 2 + 0) * 64 + lane_])), gAk = wave_max(fabsf(p.a_qk_g[(l * 2 + 1) * 64 + lane_]));
    const float gCq = wave_max(fabsf(p.c_qk_g[(l * 4 + 0) * 64 + lane_])), gCw = wave_max(fabsf(p.c_qk_g[(l * 4 + 3) * 64 + lane_]));
    const float gBqn = wave_max(fabsf(p.b_qk_nope_g[(l * 2 + 0) * 64 + lane_])), gBkn = wave_max(fabsf(p.b_qk_nope_g[(l * 2 + 1) * 64 + lane_]));
    const float gBqr = wave_max(fabsf(p.b_qk_rope_g[(l * 2 + 0) * 32 + (lane_ & 31)])), gBkr = wave_max(fabsf(p.b_qk_rope_g[(l * 2 + 1) * 32 + (lane_ & 31)]));
    const float gCk = wave_max(fabsf(p.c_qk_g[(l * 4 + 1) * 64 + lane_])); const float shC = uniform_f(1.02f * 8.0f * gCq * gCk * LOG2E);
    const float gCs = wave_max(fabsf(p.c_qk_g[(l * 4 + 2) * 64 + lane_])); const float shS = uniform_f(1.02f * 8.0f * gCq * gCs * LOG2E);
    const float shA = uniform_f(1.02f * 8.0f * gAq * gAk * LOG2E), shW = uniform_f(1.02f * 8.0f * gCq * gCw * LOG2E);
    const float shB = uniform_f(1.02f * sqrtf((64.f * gBqn * gBqn + 32.f * gBqr * gBqr) * (64.f * gBkn * gBkn + 32.f * gBkr * gBkr)) * 0.10206207261596575f * LOG2E);
    volatile LAS float* shl = (volatile LAS float*)(lds + 131072 + 64);
    __syncthreads();
    if (tl_ == 0) { shl[0] = shA; shl[1] = shB; shl[2] = shC; shl[3] = shS; shl[4] = shW; }
    __syncthreads();
    constexpr int NU = 512 + 512 + 1024;
    for (int ui = blockIdx.x; ui < NU; ui += G) {
        if (ui < 512) {
            int qt, bh;
            if (G == 256) { const int xcd = blockIdx.x & 7, loc = blockIdx.x >> 3, hs = loc >> 4, q = loc & 15; if (ui < 256) { bh = xcd + 8 * hs; qt = 15 - q; } else { bh = xcd + 8 * (2 + hs); qt = q; } }
            else { const int j = ui < 256 ? ui : 767 - ui; qt = 15 - (j >> 5); bh = j & 31; }
            AttnPtrs a{(const bf16_t*)(r1 + R1_QB), (const bf16_t*)(r1 + R1_KB), (const bf16_t*)(r1 + R1_VB), O, DM, 256, 0.10206207261596575f * LOG2E, shl[1], nullptr, nullptr, nullptr, nullptr, nullptr, nullptr, 0.f};
            for (int rep = 0; rep < UREP(0); ++rep) attn_flash<1>(lds, a, bh >> 2, bh & 3, qt);
        } else if (ui < 1024) {
            int u = ui - 512;
            if (G == 256) { const int xcd = blockIdx.x & 7, loc = blockIdx.x >> 3, r = u >> 8; u = (xcd + 8 * r) * 32 + loc; }
            AttnPtrs a{(const bf16_t*)(r2 + R2_QA), (const bf16_t*)(r2 + R2_KA), (const bf16_t*)(r2 + R2_VA), O, DM, 0, 0.125f * LOG2E, shl[0], p.a_sinks + l * 4, nullptr, nullptr, nullptr, nullptr, nullptr, 0.f};
            for (int rep = 0; rep < UREP(1); ++rep) attn_flash<0>(lds, a, u >> 6, (u >> 5) & 1, u & 31);
        } else {
            int u = ui - 1024;
            if (G == 256) { const int xcd = blockIdx.x & 7, loc = blockIdx.x >> 3, r = u >> 8;
                u = (xcd + 8 * (r >> 1)) * 64 + ((r & 1) ? loc : 63 - loc); }
            for (int rep = 0; rep < UREP(3); ++rep) {
                attn_cmp(lds, (const bf16_t*)(r2 + R2_QC), (const bf16_t*)(r2 + R2_KCMP), (const bf16_t*)(r2 + R2_VCMP), (bf16_t*)(r1 + R1_OCMP), (unsigned long long*)(r2 + R2_SEL), shl[2], u >> 7, (u >> 6) & 1, u & 63);
                asm volatile("s_waitcnt vmcnt(0)" ::: "memory");
                __syncthreads();
                AttnPtrs a{(const bf16_t*)(r2 + R2_QCR), (const bf16_t*)(r2 + R2_KS), (const bf16_t*)(r2 + R2_VS), O, DM, 512, 0.125f * LOG2E, shl[3], nullptr,
                           (const unsigned long long*)(r2 + R2_SEL), (const float*)(r2 + R2_GATES), (const bf16_t*)(r1 + R1_OCMP), (const bf16_t*)(r2 + R2_KW), (const bf16_t*)(r2 + R2_VW), shl[4]};
                attn_flash<3>(lds, a, u >> 7, (u >> 6) & 1, u & 63);
            }
        }
    }
    __syncthreads();
}
__device__ __forceinline__ void attn_phase_slc(const Params& p, LAS unsigned char* lds, int l, int G) {
    unsigned char* ws = p.ws; unsigned char* r1 = ws + WS_R1; unsigned char* r2 = ws + WS_R2;
    int tl_ = threadIdx.x; asm volatile("" : "+v"(tl_)); const int lane_ = tl_ & 63;
    const float gCq = wave_max(fabsf(p.c_qk_g[(l * 4 + 0) * 64 + lane_])), gCs = wave_max(fabsf(p.c_qk_g[(l * 4 + 2) * 64 + lane_]));
    const float shS = uniform_f(1.02f * 8.0f * gCq * gCs * LOG2E);
    const float gCw2 = wave_max(fabsf(p.c_qk_g[(l * 4 + 3) * 64 + lane_])); const float shW2 = uniform_f(1.02f * 8.0f * gCq * gCw2 * LOG2E);
    for (int u0 = blockIdx.x; u0 < 1024; u0 += G) {
        int u = u0;
        if (G == 256) { const int xcd = blockIdx.x & 7, loc = blockIdx.x >> 3, r = u0 >> 8;
            u = (xcd + 8 * (r >> 1)) * 64 + ((r & 1) ? loc : 63 - loc); }
        AttnPtrs a{(const bf16_t*)(r2 + R2_QCR), (const bf16_t*)(r2 + R2_KS), (const bf16_t*)(r2 + R2_VS), (bf16_t*)(ws + WS_U), DM, 512, 0.125f * LOG2E, shS, nullptr,
                   (const unsigned long long*)(r2 + R2_SEL), (const float*)(r2 + R2_GATES), (const bf16_t*)(r1 + R1_OCMP), (const bf16_t*)(r2 + R2_KW), (const bf16_t*)(r2 + R2_VW), shW2};
        attn_flash<3>(lds, a, u >> 7, (u >> 6) & 1, u & 63);
    }
    __syncthreads();
}

__global__ void __launch_bounds__(NTHREADS, 2) fwd_megakernel(Params p) {
    extern __shared__ __attribute__((aligned(16))) unsigned char smem[];
    LAS unsigned char* lds = (LAS unsigned char*)smem;
    cg::grid_group grid = cg::this_grid();
    const int G = gridDim.x, ngw = G * NWAVES;
    volatile LAS unsigned* bst = (volatile LAS unsigned*)(lds + 131072);
    if (threadIdx.x < 2) bst[threadIdx.x] = 0u;
    __syncthreads();
    (void)xcd_barrier_post((unsigned*)(p.ws + WS_BAR), bst);
    for (int ph = p.ph_lo; ph < p.ph_hi; ++ph) {
        bool nosync = false;
#define MKLANE int tid_ = threadIdx.x; asm volatile("" : "+v"(tid_)); const int tid = tid_, lane = tid & 63, wave = __builtin_amdgcn_readfirstlane(tid >> 6), gw = blockIdx.x * NWAVES + wave; (void)tid; (void)lane; (void)wave; (void)gw;
        unsigned char* ws = p.ws; asm volatile("" : "+s"(ws));
        if (ph == 0) { MKLANE if (PHON(0)) for (int rep = 0; rep < NREP(0); ++rep) { prologue(p, lds, tid, wave, lane, G); __syncthreads(); } }
        else {
            const int l = (ph - 1) / 16, k = (ph - 1) % 16;
            const float* modl = (const float*)(ws + WS_MOD) + (size_t)l * NBATCH * NMOD * DM;
            if (PHON(1) && (k == 0 || k == 3 || k == 13) && !(FUSE_NORM && G == 256 && !(l == 0 && k == 0))) {
                MKLANE
                const int j = k == 0 ? 0 : (k == 3 ? 1 : 2);
                const float* hin = (l == 0 && k == 0) ? p.x : p.out;
                if (l == 0 && k == 0 && blockIdx.x == 0) {
                    const float* CMPBP = (const float*)(ws + WS_CMPBP); float* CMPB = (float*)(ws + WS_CMPB);
                    for (int i = tid; i < 8 * 128; i += NTHREADS) { const int m = i >> 7, n = i & 127; float a = 0.f;
                        for (int sl = 0; sl < 32; ++sl) a += CMPBP[((size_t)m * 32 + sl) * 128 + n];
                        CMPB[i] = a; }
                }
                for (int rep = 0; rep < NREP(1); ++rep) norm_phase(hin, (bf16_t*)(ws + WS_U), p.norm_g + (size_t)(l * 3 + j) * DM, modl, 3 * j + 1, 3 * j, gw, ngw, lane);
            } else if (PHON(2) && (k == 1 || k == 14)) {
                const int f = k == 1 ? 0 : 1;
                pg8::Gemm g{(const bf16_t*)(ws + WS_U), (const bf16_t*)(ws + WS_W1T) + (size_t)(l * 2 + f) * 2 * DFF * DM, DM, DM, T, 2 * DFF, DM};
                pg8::StaticOrder S; S.init(g.M, g.N, G, blockIdx.x);
                pg8::EpiSwiglu E{(bf16_t*)(ws + WS_R1)};
                for (int rep = 0; rep < NREP(2); ++rep) pg8::gemm_phase(lds, g, S, E);
            } else if (PHON(3) && (k == 2 || k == 12 || k == 15)) {
                pg8::Gemm g;
                if (k == 12) g = pg8::Gemm{(const bf16_t*)(ws + WS_U), (const bf16_t*)(ws + WS_WOUTT) + (size_t)l * DM * DM, DM, DM, T, DM, DM};
                else g = pg8::Gemm{(const bf16_t*)(ws + WS_R1), (const bf16_t*)(ws + WS_W2T) + (size_t)(l * 2 + (k == 2 ? 0 : 1)) * DM * DFF, DFF, DFF, T, DM, DFF};
                pg8::StaticOrder S; S.init(g.M, g.N, G, blockIdx.x);
                const int gi = k == 2 ? 2 : (k == 12 ? 5 : 8);
                for (int rep = 0; rep < NREP(3); ++rep) {
                    const bool fuse = FUSE_NORM && G == 256 && !(k == 15 && l == DEPTH - 1) && (rep + 1 == NREP(3));
                    const int ln = k == 15 ? l + 1 : l, jn = k == 2 ? 1 : (k == 12 ? 2 : 0), call = l * 3 + (k == 2 ? 0 : (k == 12 ? 1 : 2));
                    const float* modn = (const float*)(ws + WS_MOD) + (size_t)ln * NBATCH * NMOD * DM;
                    pg8::EpiResid E{(l == 0 && k == 2) ? p.x : p.out, p.out, modl + gi * DM, (rep + 1 < NREP(3)) ? 0.0f : (k == 12 ? 1.0f : 0.5f),
                                    fuse ? p.norm_g + (size_t)(ln * 3 + jn) * DM : nullptr, modn + (3 * jn + 1) * DM, modn + (3 * jn) * DM, (bf16_t*)(ws + WS_U), (float*)(ws + WS_XBUF),
                                    (unsigned*)(ws + WS_BAR + 16384) + call * 128, lds + 131072 + 256};
                    pg8::gemm_phase(lds, g, S, E);
                }
            } else if (PHON(4) && k == 4) {
                pg8::Gemm g{(const bf16_t*)(ws + WS_U), (const bf16_t*)(ws + WS_WINT) + (size_t)l * DINP * DM, DM, DM, T, DINP, DM};
                unsigned char* r2 = ws + WS_R2;
                pg8::EpiMixIn E{(bf16_t*)(r2 + R2_QA), (bf16_t*)(r2 + R2_KA), (bf16_t*)(r2 + R2_VA), (bf16_t*)(r2 + R2_QC), (bf16_t*)(r2 + R2_QCR), (bf16_t*)(r2 + R2_ZK), (bf16_t*)(r2 + R2_ZV),
                                (bf16_t*)(r2 + R2_KS), (bf16_t*)(r2 + R2_VS), (bf16_t*)(r2 + R2_KW), (bf16_t*)(r2 + R2_VW), (bf16_t*)(ws + WS_R1),
                                p.a_qk_g + (l * 2 + 0) * 64, p.a_qk_g + (l * 2 + 1) * 64, p.c_qk_g + (l * 4 + 0) * 64, p.c_qk_g + (l * 4 + 2) * 64, p.c_qk_g + (l * 4 + 3) * 64,
                                (const float*)(ws + WS_COS64), (const float*)(ws + WS_SIN64)};
                pg8::StaticOrder S; S.init(g.M, g.N, G, blockIdx.x);
                for (int rep = 0; rep < NREP(4); ++rep) pg8::gemm_phase(lds, g, S, E);
            } else if (PHON(4) && (k == 6 || k == 7)) {
                pg8::Gemm g;
                if (k == 6) g = pg8::Gemm{(const bf16_t*)(ws + WS_R2 + R2_CQN), (const bf16_t*)(ws + WS_WUQT) + (size_t)l * 512 * 256, 256, 256, T, 512, 256};
                else g = pg8::Gemm{(const bf16_t*)(ws + WS_R2 + R2_CKVN), (const bf16_t*)(ws + WS_WUKVT) + (size_t)l * 512 * 128, 128, 128, T, 512, 128};
                pg8::EpiMixB E{k == 6, (bf16_t*)(ws + WS_R1 + R1_QB), (bf16_t*)(ws + WS_R1 + R1_KB), (bf16_t*)(ws + WS_R1 + R1_VB), (const bf16_t*)(ws + WS_R2 + R2_KPE),
                               p.b_qk_nope_g + (l * 2 + 0) * 64, p.b_qk_rope_g + (l * 2 + 0) * 32, p.b_qk_nope_g + (l * 2 + 1) * 64, (const float*)(ws + WS_COS32), (const float*)(ws + WS_SIN32)};
                pg8::StaticOrder S; S.init(g.M, g.N, G, blockIdx.x);
                for (int rep = 0; rep < NREP(4); ++rep) pg8::gemm_phase(lds, g, S, E);
                if (k == 7 && PHON(6)) { MKLANE for (int rep = 0; rep < NREP(6); ++rep) postproc_b(p, lds, l, gw, ngw, lane); }
            } else if (PHON(5) && k == 5) {
                { MKLANE
                  for (int rep = 0; rep < NREP(5); ++rep) postproc_a2(p, lds, l, gw, ngw, lane); }
                __syncthreads();
                pg8::Gemm g{(const bf16_t*)(ws + WS_R2 + R2_ZK), (const bf16_t*)(ws + WS_WC1T) + (size_t)l * 256 * 2048, 1024, 2048, 8192, 256, 512, 1024};
                pg8::StaticOrder S; S.init(g.M, 4 * 256, G, blockIdx.x);
                pg8::EpiCmp E{(float*)(ws + WS_R1 + R1_HIDP)};
                for (int rep = 0; rep < NREP(9); ++rep) pg8::gemm_phase(lds, g, S, E);
            } else if (PHON(7) && k == 10) {
                for (int rep = 0; rep < NREP(7); ++rep) attn_phase_main(p, lds, l, G);
            }
            nosync = (k == 6 || k == 8 || k == 9 || k == 11) || (FUSE_NORM && G == 256 && (k == 0 || k == 3 || k == 13) && !(l == 0 && k == 0));
        }
        if (ph + 1 < p.ph_hi && !nosync) for (int rep = 0; rep < NREP(10); ++rep) {
            if (ph == 0) grid.sync();
            else { XcdBarrier xb_; xb_.bar = (unsigned*)(p.ws + WS_BAR); xb_.x = xb_xcc_id(); xb_.st = (volatile LAS unsigned*)(lds + 131072); xcd_barrier(xb_); }
        }
    }
}

constexpr int LDS_BYTES = 144 * 1024;
constexpr int NPHASES = 1 + 16 * DEPTH;
extern "C" void kernel_launch(void* const* d_in, const int* in_sizes, int n_in, void* d_out, int out_size, void* d_ws, size_t ws_size, hipStream_t stream) {
    static int grid = 0;
    if (grid == 0) {
        if (n_in != 24 || out_size != T * DM || ws_size < WS_END) { fprintf(stderr, "kernel_launch: unexpected problem (n_in %d, out %d, ws %zu; need ws >= %zu)\n", n_in, out_size, ws_size, (size_t)WS_END); grid = -1; return; }
        int dev = 0, cus = 0, per_cu = 0;
        hipGetDevice(&dev);
        hipDeviceGetAttribute(&cus, hipDeviceAttributeMultiprocessorCount, dev);
        if (hipFuncSetAttribute((const void*)fwd_megakernel, hipFuncAttributeMaxDynamicSharedMemorySize, LDS_BYTES) != hipSuccess) { fprintf(stderr, "kernel_launch: hipFuncSetAttribute failed\n"); grid = -1; return; }
        if (hipOccupancyMaxActiveBlocksPerMultiprocessor(&per_cu, (const void*)fwd_megakernel, NTHREADS, LDS_BYTES) != hipSuccess || per_cu < 1) { fprintf(stderr, "kernel_launch: occupancy query says %d\n", per_cu); per_cu = 1; }
        (void)hipGetLastError();
        grid = cus * 1;
        fprintf(stderr, "kernel_launch: grid %d (occupancy %d/CU)\n", grid, per_cu);
    }
    if (grid < 0) return;
    Params p{};
    const float** fp = (const float**)&p;
    for (int i = 0; i < 24; ++i) fp[i] = (const float*)d_in[i];
    p.out = (float*)d_out; p.ws = (unsigned char*)d_ws;
#if MK_ONE_LAUNCH
    if (hipMemsetAsync((unsigned char*)d_ws + WS_BAR, 0, BAR_BYTES, stream) != hipSuccess) { fprintf(stderr, "kernel_launch: memset failed\n"); return; }
    p.ph_lo = 0; p.ph_hi = NPHASES;
    void* args[] = {&p};
    hipError_t e = hipLaunchCooperativeKernel((const void*)fwd_megakernel, dim3(grid), dim3(NTHREADS), args, LDS_BYTES, stream);
    if (e != hipSuccess) fprintf(stderr, "kernel_launch: cooperative launch failed: %s (grid %d)\n", hipGetErrorString(e), grid);
#else
    for (int ph = 0; ph < NPHASES; ++ph) { p.ph_lo = ph; p.ph_hi = ph + 1; hipLaunchKernelGGL(fwd_megakernel, dim3(grid), dim3(NTHREADS), LDS_BYTES, stream, p); }
#endif
}
```
